# Optimizing an MI355X kernel written in HIP

```python
import jax, jax.numpy as jnp
from jax import lax
import numpy as np

D_MODEL = 2048
BATCH = 2
SEQ = 4096
DEPTH = 2

HEAD_DIM = 128
MIX_WIDTH = D_MODEL
MLSTM_WIDTH = MIX_WIDTH // 4
MLSTM_HEADS = MLSTM_WIDTH // HEAD_DIM
MLSTM_CHUNK = 64
MOBA_WIDTH = MIX_WIDTH // 2
MOBA_HEADS = MOBA_WIDTH // HEAD_DIM
MOBA_BLOCK = 256
MOBA_TOPK = 3
MOBA_QBLOCK = 32
ROPE_THETA = 500000.0
ROPE_DIM = HEAD_DIM // 4
GMLP_WIDTH = MIX_WIDTH // 4
GMLP_GROUP_DIM = 128
GMLP_GROUPS = GMLP_WIDTH // GMLP_GROUP_DIM
GMLP_CHUNK = 128
N_BRANCHES = 3
D_FF = 4 * D_MODEL
PLE_DIM = 256
NORM_EPS = 1e-6

IN_SPLITS = (MLSTM_WIDTH, MLSTM_WIDTH, MLSTM_WIDTH, MLSTM_WIDTH, MLSTM_HEADS, MLSTM_HEADS,
             MOBA_WIDTH, MOBA_WIDTH, MOBA_WIDTH, GMLP_WIDTH, GMLP_WIDTH, N_BRANCHES * D_MODEL)
IN_COLS = sum(IN_SPLITS)
IN_OFFSETS = np.cumsum(IN_SPLITS)[:-1].tolist()

kernel_name = 'hybrid_mlstm_moba_gmlp_block'


def rmsnorm(x, g):
    xf = x.astype(jnp.float32)
    y = xf * lax.rsqrt(jnp.mean(xf * xf, axis=-1, keepdims=True) + NORM_EPS)
    return (y * g.astype(jnp.float32)).astype(x.dtype)


def layernorm(x, g, b):
    xf = x.astype(jnp.float32)
    mu = jnp.mean(xf, axis=-1, keepdims=True)
    xc = xf - mu
    y = xc * lax.rsqrt(jnp.mean(xc * xc, axis=-1, keepdims=True) + NORM_EPS)
    return (y * g.astype(jnp.float32) + b.astype(jnp.float32)).astype(x.dtype)


def to_heads(t, n):
    b, s, _ = t.shape
    return t.reshape(b, s, n, -1).transpose(0, 2, 1, 3)


def from_heads(t):
    b, h, s, d = t.shape
    return t.transpose(0, 2, 1, 3).reshape(b, s, h * d)


def partial_rotary(t):
    s = t.shape[2]
    half = ROPE_DIM // 2
    inv_freq = ROPE_THETA ** (-jnp.arange(0, ROPE_DIM, 2, dtype=jnp.float32) / ROPE_DIM)
    ang = jnp.arange(s, dtype=jnp.float32)[:, None] * inv_freq[None, :]
    cos = jnp.cos(ang).astype(t.dtype)
    sin = jnp.sin(ang).astype(t.dtype)
    t1 = t[..., :half]
    t2 = t[..., half:ROPE_DIM]
    return jnp.concatenate([t1 * cos - t2 * sin, t2 * cos + t1 * sin, t[..., ROPE_DIM:]], axis=-1)


def mlstm_chunkwise(q, k, v, i_pre, f_pre):
    b, h, s, d = q.shape
    f32 = jnp.float32
    L = MLSTM_CHUNK
    nc = s // L
    q = q.astype(f32)
    k = k.astype(f32) * (d ** -0.5)
    v = v.astype(f32)
    log_f = jax.nn.log_sigmoid(f_pre.astype(f32))
    i_g = i_pre.astype(f32)

    def chunks(a):
        return jnp.moveaxis(a.reshape((b, h, nc, L) + a.shape[3:]), 2, 0)

    xs = (chunks(q), chunks(k), chunks(v), chunks(log_f), chunks(i_g))
    causal = jnp.tril(jnp.ones((L, L), dtype=bool))

    def step(carry, inp):
        C, n, m = carry
        qc, kc, vc, lf, ig = inp
        g = jnp.cumsum(lf, axis=-1)
        log_w = jnp.where(causal, g[..., :, None] - g[..., None, :] + ig[..., None, :], -jnp.inf)
        log_a = g + m[..., None]
        m_row = jnp.maximum(jnp.max(log_w, axis=-1), log_a)
        qk = jnp.einsum('bhld,bhsd->bhls', qc, kc) * jnp.exp(log_w - m_row[..., None])
        a = jnp.exp(log_a - m_row)
        num = jnp.einsum('bhls,bhsd->bhld', qk, vc) + a[..., None] * jnp.einsum('bhvk,bhlk->bhlv', C, qc)
        den = jnp.sum(qk, axis=-1) + a * jnp.einsum('bhk,bhlk->bhl', n, qc)
        h_out = num / jnp.maximum(jnp.abs(den), jnp.exp(-m_row))[..., None]
        g_last = g[..., -1]
        log_u = g_last[..., None] - g + ig
        m_new = jnp.maximum(g_last + m, jnp.max(log_u, axis=-1))
        decay = jnp.exp(g_last + m - m_new)
        u = jnp.exp(log_u - m_new[..., None])
        C = decay[..., None, None] * C + jnp.einsum('bhl,bhlv,bhlk->bhvk', u, vc, kc)
        n = decay[..., None] * n + jnp.einsum('bhl,bhlk->bhk', u, kc)
        return (C, n, m_new), h_out

    init = (jnp.zeros((b, h, d, d), f32), jnp.zeros((b, h, d), f32), jnp.zeros((b, h), f32))
    _, hs = lax.scan(step, init, xs)
    return jnp.moveaxis(hs, 0, 2).reshape(b, h, s, d)


def moba_attention(q, k, v):
    b, h, s, d = q.shape
    blk = MOBA_BLOCK
    nb = -(-s // blk)
    pad = nb * blk - s
    kp = jnp.pad(k, ((0, 0), (0, 0), (0, pad), (0, 0))).reshape(b, h, nb, blk, d)
    vp = jnp.pad(v, ((0, 0), (0, 0), (0, pad), (0, 0))).reshape(b, h, nb, blk, d)
    k_mean = jnp.mean(kp.astype(jnp.float32), axis=3)
    q_blk = jnp.arange(s) // blk
    gate = jnp.einsum('bhsd,bhnd->bhsn', q.astype(jnp.float32), k_mean)
    fully_past = jnp.arange(nb)[None, :] < q_blk[:, None]
    gate = jnp.where(fully_past, gate, -jnp.inf)
    k_top = min(MOBA_TOPK, nb)
    _, sel = lax.top_k(gate, k_top)
    sel_valid = jnp.arange(k_top)[None, :] < q_blk[:, None]
    scale = d ** -0.5
    b_idx = jnp.arange(b)[:, None, None, None]
    h_idx = jnp.arange(h)[None, :, None, None]
    qb = MOBA_QBLOCK

    def one_block(s0):
        qc = lax.dynamic_slice_in_dim(q, s0, qb, axis=2)
        sel_c = lax.dynamic_slice_in_dim(sel, s0, qb, axis=2)
        valid_c = lax.dynamic_slice_in_dim(sel_valid, s0, qb, axis=0)
        k_sel = kp[b_idx, h_idx, sel_c]
        v_sel = vp[b_idx, h_idx, sel_c]
        own = s0 // blk
        k_own = lax.dynamic_index_in_dim(kp, own, axis=2, keepdims=False)
        v_own = lax.dynamic_index_in_dim(vp, own, axis=2, keepdims=False)
        s_sel = jnp.einsum('bhqd,bhqjkd->bhqjk', qc, k_sel).astype(jnp.float32) * scale
        s_sel = jnp.where(valid_c[None, None, :, :, None], s_sel, -jnp.inf).reshape(b, h, qb, k_top * blk)
        s_own = jnp.einsum('bhqd,bhkd->bhqk', qc, k_own).astype(jnp.float32) * scale
        key_pos = own * blk + jnp.arange(blk)
        q_pos = s0 + jnp.arange(qb)
        s_own = jnp.where(key_pos[None, :] <= q_pos[:, None], s_own, -jnp.inf)
        probs = jax.nn.softmax(jnp.concatenate([s_sel, s_own], axis=-1), axis=-1).astype(v.dtype)
        p_sel = probs[..., :k_top * blk].reshape(b, h, qb, k_top, blk)
        p_own = probs[..., k_top * blk:]
        return (jnp.einsum('bhqjk,bhqjkd->bhqd', p_sel, v_sel)
                + jnp.einsum('bhqk,bhkd->bhqd', p_own, v_own))

    outs = lax.map(one_block, jnp.arange(s // qb) * qb)
    return jnp.moveaxis(outs, 0, 2).reshape(b, h, s, d)


def spatial_gating(u, v, norm_g, norm_b, w_s, b_s):
    b, s, _ = v.shape
    nc = s // GMLP_CHUNK
    v = layernorm(v, norm_g, norm_b).reshape(b, nc, GMLP_CHUNK, GMLP_GROUPS, GMLP_GROUP_DIM)
    w = w_s * jnp.tril(jnp.ones((GMLP_CHUNK, GMLP_CHUNK), dtype=w_s.dtype))[None]
    mixed = jnp.einsum('gts,bcsge->bctge', w, v) + b_s.T[None, None, :, :, None]
    return u * mixed.reshape(b, s, GMLP_WIDTH)


def setup_inputs(seed: int = 0) -> dict:
    key = jax.random.key(seed)
    ks = jax.random.split(key, 24)

    def nrm(k, shape, scale):
        return jax.random.normal(k, shape, jnp.float32) * scale

    def gain(k, shape):
        return 1.0 + nrm(k, shape, 0.05)

    gate_b = jnp.concatenate([nrm(ks[3], (DEPTH, MLSTM_HEADS), 0.1),
                              3.0 + nrm(ks[4], (DEPTH, MLSTM_HEADS), 0.5)], axis=-1)
    return {
        'x': nrm(ks[0], (BATCH, SEQ, D_MODEL), 1.0),
        'p': nrm(ks[1], (DEPTH, BATCH, SEQ, PLE_DIM), 1.0),
        'norm_mix_g': gain(ks[2], (DEPTH, D_MODEL)),
        'w_in': nrm(ks[5], (DEPTH, D_MODEL, IN_COLS), D_MODEL ** -0.5),
        'mlstm_gate_b': gate_b,
        'mlstm_norm_g': gain(ks[6], (DEPTH, MLSTM_WIDTH)),
        'gmlp_norm_g': gain(ks[7], (DEPTH, GMLP_WIDTH)),
        'gmlp_norm_b': nrm(ks[8], (DEPTH, GMLP_WIDTH), 0.02),
        'gmlp_ws': nrm(ks[9], (DEPTH, GMLP_GROUPS, GMLP_CHUNK, GMLP_CHUNK), 0.5 * GMLP_CHUNK ** -0.5),
        'gmlp_bs': 1.0 + nrm(ks[10], (DEPTH, GMLP_GROUPS, GMLP_CHUNK), 0.1),
        'w_branch_a': nrm(ks[11], (DEPTH, MLSTM_WIDTH, D_MODEL), MLSTM_WIDTH ** -0.5),
        'w_branch_b': nrm(ks[12], (DEPTH, MOBA_WIDTH, D_MODEL), MOBA_WIDTH ** -0.5),
        'w_branch_c': nrm(ks[13], (DEPTH, GMLP_WIDTH, D_MODEL), GMLP_WIDTH ** -0.5),
        'w_out': nrm(ks[14], (DEPTH, D_MODEL, D_MODEL), D_MODEL ** -0.5),
        'norm_mlp_g': gain(ks[15], (DEPTH, D_MODEL)),
        'w_mlp_up': nrm(ks[16], (DEPTH, D_MODEL, D_FF), D_MODEL ** -0.5),
        'w_mlp_down': nrm(ks[17], (DEPTH, D_FF, D_MODEL), D_FF ** -0.5),
        'norm_ple_g': gain(ks[18], (DEPTH, D_MODEL)),
        'w_ple_gate': nrm(ks[19], (DEPTH, D_MODEL, D_MODEL), D_MODEL ** -0.5),
        'w_ple_proj': nrm(ks[20], (DEPTH, PLE_DIM, D_MODEL), PLE_DIM ** -0.5),
        'final_norm_g': gain(ks[21], (D_MODEL,)),
    }


def reference(x, p, norm_mix_g, w_in, mlstm_gate_b, mlstm_norm_g, gmlp_norm_g, gmlp_norm_b,
              gmlp_ws, gmlp_bs, w_branch_a, w_branch_b, w_branch_c, w_out, norm_mlp_g,
              w_mlp_up, w_mlp_down, norm_ple_g, w_ple_gate, w_ple_proj, final_norm_g):
    b, s, _ = x.shape
    for i in range(DEPTH):
        h = rmsnorm(x, norm_mix_g[i])
        z = h @ w_in[i]
        (qa, ka, va, oa, ia, fa, qb_, kb_, vb_, uc, vc, zg) = jnp.split(z, IN_OFFSETS, axis=-1)

        i_pre = (ia + mlstm_gate_b[i, :MLSTM_HEADS]).transpose(0, 2, 1)
        f_pre = (fa + mlstm_gate_b[i, MLSTM_HEADS:]).transpose(0, 2, 1)
        h_til = mlstm_chunkwise(to_heads(qa, MLSTM_HEADS), to_heads(ka, MLSTM_HEADS),
                                to_heads(va, MLSTM_HEADS), i_pre, f_pre).astype(x.dtype)
        h_til = from_heads(h_til).reshape(b, s, MLSTM_HEADS, HEAD_DIM)
        y_a = rmsnorm(h_til, jnp.ones((HEAD_DIM,), x.dtype)).reshape(b, s, MLSTM_WIDTH)
        y_a = jax.nn.sigmoid(oa) * (y_a * mlstm_norm_g[i])

        qh = partial_rotary(to_heads(qb_, MOBA_HEADS))
        kh = partial_rotary(to_heads(kb_, MOBA_HEADS))
        y_b = from_heads(moba_attention(qh, kh, to_heads(vb_, MOBA_HEADS)))

        y_c = spatial_gating(jax.nn.gelu(uc), jax.nn.gelu(vc), gmlp_norm_g[i], gmlp_norm_b[i],
                             gmlp_ws[i], gmlp_bs[i])

        gates = jax.nn.sigmoid(zg).reshape(b, s, N_BRANCHES, D_MODEL)
        merged = (gates[:, :, 0] * (y_a @ w_branch_a[i])
                  + gates[:, :, 1] * (y_b @ w_branch_b[i])
                  + gates[:, :, 2] * (y_c @ w_branch_c[i]))
        x = x + merged @ w_out[i]

        h2 = rmsnorm(x, norm_mlp_g[i])
        x = x + jnp.square(jax.nn.relu(h2 @ w_mlp_up[i])) @ w_mlp_down[i]

        g_ple = jax.nn.sigmoid(rmsnorm(x, norm_ple_g[i]) @ w_ple_gate[i])
        x = x + g_ple * (p[i] @ w_ple_proj[i])
    return rmsnorm(x, final_norm_g)
```

```cpp
#include <hip/hip_runtime.h>
#include <hip/hip_cooperative_groups.h>
#include <cstdio>
namespace cg = cooperative_groups;
namespace pg8 {
#define PG8_LAS __attribute__((address_space(3)))
typedef unsigned short bf16_t;
typedef short bf16x8 __attribute__((ext_vector_type(8)));
typedef float f32x4 __attribute__((ext_vector_type(4)));
typedef unsigned u32x4 __attribute__((ext_vector_type(4)));
constexpr int BM = 256, BK = 64, HALF = 128, HTB = HALF * BK * 2  , STAGE_BYTES = 8 * HTB, NXCD = 8, WGM = 8;

__host__ __device__ __forceinline__ int lds_byte(int r, int c) { const int st = (r >> 4) * 2 + (c >> 5), rr = r & 15, cc = c & 31, ob = rr * 64 + cc * 2; return st * 1024 + (ob ^ (((ob >> 9) & 1) << 5)); }
__host__ __device__ __forceinline__ void stage_rc(int b, int& R, int& C) { const int st = b / 1024, sb = b % 1024, swz = sb ^ (((sb >> 9) & 1) << 5); R = (st >> 1) * 16 + swz / 64; C = (st & 1) * 32 + (swz % 64) / 2; }
__host__ __device__ __forceinline__ int perm32(int rho) { const int n = rho >> 4, i = rho & 15; return 8 * (i >> 2) + 4 * n + (i & 3); }

struct Unit { int pm, pn; };
struct Gemm { const bf16_t* A; const bf16_t* Bt; int M, N, K; };

struct StaticOrder {
    int nM, nN, nwg, G, c;
    __host__ __device__ void init(int M, int N, int G_, int c_) { nM = M / BM; nN = N / BM; nwg = nM * nN; G = G_; c = c_; }
    __host__ __device__ bool next(int i, Unit& u) const {
        const long L = (long)i * G + c; if (L >= nwg) return false;
        int wgid = (int)L; { const int q = nwg / NXCD, r = nwg % NXCD, xcd = wgid % NXCD, off = wgid / NXCD; wgid = (xcd < r ? xcd * (q + 1) : r * (q + 1) + (xcd - r) * q) + off; }
        const int nig = WGM * nN, gid = wgid / nig, fm = gid * WGM, gsz = (nM - fm) < WGM ? (nM - fm) : WGM;
        u.pm = fm + ((wgid % nig) % gsz); u.pn = (wgid % nig) / gsz; return true;
    }
    __device__ __forceinline__ void a_ready(const Unit&) const {}
    __device__ __forceinline__ void done(const Unit&) const {}
};
__device__ __forceinline__ unsigned cvt_pk_bf16(float lo, float hi) { unsigned r; asm volatile("v_cvt_pk_bf16_f32 %0, %1, %2" : "=v"(r) : "v"(lo), "v"(hi)); return r; }
typedef float f32x2 __attribute__((ext_vector_type(2)));
template <class Epi, class Sched, bool STAMP = false>
__device__ __forceinline__ void gemm_phase(PG8_LAS unsigned char* lds, const Gemm g, const Sched& S, const Epi& E, unsigned long long* stamps) {
    int tid_ = threadIdx.x; asm volatile("" : "+v"(tid_)); const int tid = tid_, wid = __builtin_amdgcn_readfirstlane(tid >> 6), lane = tid & 63, wr = wid >> 2, wc = wid & 3, fr = lane & 15, fq = lane >> 4;
    const int K = g.K, nt = K / BK;
    int ts_lo = 0, ts_hi = 0, nts = 0; const unsigned long long rt_entry = STAMP ? (unsigned long long)wall_clock64() : 0ull;
#define PG8_STAMP() do { if (STAMP && wid == 0 && nts < 64) { const unsigned long long _c = (unsigned long long)clock64(); \
        ts_lo = (lane == nts) ? (int)(unsigned)_c : ts_lo; ts_hi = (lane == nts) ? (int)(unsigned)(_c >> 32) : ts_hi; ++nts; } } while (0)
    PG8_STAMP();
    unsigned voffA[2], voffB[2];
#pragma unroll
    for (int i = 0; i < 2; ++i) { int R, C; stage_rc(tid * 16 + i * 8192, R, C); const int Rb = Epi::PERM ? ((R & ~31) + perm32(R & 31)) : R;
        voffA[i] = (unsigned)(R * K + C) * 2u; voffB[i] = (unsigned)(Rb * K + C) * 2u; }
    const size_t kstep = (size_t)(BK * 2);
    const size_t hstep = (size_t)HALF * K * 2;
    const size_t tstep = 2 * hstep;
    const unsigned ldsw = (unsigned)wid * 1024u;
    const int aoff = lds_byte(wr * 64 + fr, fq * 8), boff = lds_byte(wc * 32 + fr, fq * 8);
#define PG8_SA(b, h) (((b) * 2 + (h)) * HTB)
#define PG8_SB(b, h) ((4 + (b) * 2 + (h)) * HTB)
#define PG8_STAGE(bufoff, gbase, voff) do { _Pragma("unroll") for (int _i = 0; _i < 2; ++_i) \
        __builtin_amdgcn_global_load_lds((const unsigned*)((const char*)(gbase) + (voff)[_i]), (PG8_LAS unsigned*)(lds + (bufoff) + ldsw + _i * 8192), 16, 0, 0); } while (0)
#define PG8_LDA(dst, b, h) do { _Pragma("unroll") for (int m = 0; m < 4; ++m) _Pragma("unroll") for (int k = 0; k < 2; ++k) dst[m][k] = *(const PG8_LAS bf16x8*)(lds + PG8_SA(b, h) + aoff + m * 2048 + k * 1024); } while (0)
#define PG8_LDB(dst, b, h) do { _Pragma("unroll") for (int n = 0; n < 2; ++n) _Pragma("unroll") for (int k = 0; k < 2; ++k) dst[n][k] = *(const PG8_LAS bf16x8*)(lds + PG8_SB(b, h) + boff + n * 2048 + k * 1024); } while (0)
#define PG8_MMA(ai, bj, At, Bt) do { __builtin_amdgcn_s_setprio(1); _Pragma("unroll") for (int m = 0; m < 4; ++m) _Pragma("unroll") for (int n = 0; n < 2; ++n) _Pragma("unroll") for (int k = 0; k < 2; ++k) \
        acc[ai][bj][m][n] = __builtin_amdgcn_mfma_f32_16x16x32_bf16(Bt[n][k], At[m][k], acc[ai][bj][m][n], 0, 0, 0); __builtin_amdgcn_s_setprio(0); } while (0)
#define PG8_WAIT_V(n) asm volatile("s_waitcnt vmcnt(" #n ")" ::: "memory")
#define PG8_WAIT_L(n) asm volatile("s_waitcnt lgkmcnt(" #n ")" ::: "memory")
#define PG8_BAR __builtin_amdgcn_s_barrier()
#define PG8_SCHED __builtin_amdgcn_sched_barrier(0)
    Unit cur, nxt; int ui = 0;
    if (!S.next(0, cur)) return;
    f32x4 acc[2][2][4][2];
#pragma unroll
    for (int a = 0; a < 2; ++a)
#pragma unroll
        for (int b = 0; b < 2; ++b)
#pragma unroll
            for (int m = 0; m < 4; ++m)
#pragma unroll
                for (int n = 0; n < 2; ++n) acc[a][b][m][n] = (f32x4){0.f, 0.f, 0.f, 0.f};
    bf16x8 At[4][2], B0[2][2], B1[2][2];
    const char* cA = (const char*)g.A + (size_t)cur.pm * tstep; const char* cB = (const char*)g.Bt + (size_t)cur.pn * tstep;
    S.a_ready(cur);
    PG8_STAGE(PG8_SB(0, 0), cB, voffB); PG8_STAGE(PG8_SA(0, 0), cA, voffA); PG8_STAGE(PG8_SB(0, 1), cB + hstep, voffB); PG8_STAGE(PG8_SA(0, 1), cA + hstep, voffA);
    if (wr == 1) PG8_BAR;
    PG8_WAIT_V(4); PG8_BAR;
    PG8_STAGE(PG8_SB(1, 0), cB + kstep, voffB); PG8_STAGE(PG8_SA(1, 0), cA + kstep, voffA); PG8_STAGE(PG8_SB(1, 1), cB + hstep + kstep, voffB);
    PG8_WAIT_V(6); PG8_BAR;
    PG8_STAMP();
    for (;;) {
        const bool has_next = S.next(ui + 1, nxt);
        const char* nA = has_next ? (const char*)g.A + (size_t)nxt.pm * tstep : cA; const char* nB = has_next ? (const char*)g.Bt + (size_t)nxt.pn * tstep : cB;
        for (int t = 0; t < nt; t += 2) {
            const bool last = (t == nt - 2);
            const char* a1 = cA + (size_t)(t + 1) * kstep;
            const char* a2 = last ? nA : cA + (size_t)(t + 2) * kstep; const char* b2 = last ? nB : cB + (size_t)(t + 2) * kstep;
            const char* a3 = a2 + kstep; const char* b3 = b2 + kstep;
            if (last && has_next) S.a_ready(nxt);
            PG8_LDB(B0, 0, 0); PG8_SCHED; PG8_LDA(At, 0, 0); PG8_STAGE(PG8_SA(1, 1), a1 + hstep, voffA);
            PG8_WAIT_L(8); PG8_BAR; PG8_WAIT_L(0); PG8_MMA(0, 0, At, B0); PG8_BAR; PG8_SCHED;
            PG8_LDB(B1, 0, 1); PG8_STAGE(PG8_SB(0, 0), b2, voffB);
            PG8_BAR; PG8_WAIT_L(0); PG8_MMA(0, 1, At, B1); PG8_BAR;
            PG8_LDA(At, 0, 1); PG8_STAGE(PG8_SA(0, 0), a2, voffA);
            PG8_BAR; PG8_WAIT_L(0); PG8_MMA(1, 0, At, B0); PG8_BAR; PG8_SCHED;
            PG8_STAGE(PG8_SB(0, 1), b2 + hstep, voffB);
            PG8_WAIT_V(6); PG8_BAR; PG8_MMA(1, 1, At, B1); PG8_BAR;
            PG8_LDB(B0, 1, 0); PG8_SCHED; PG8_LDA(At, 1, 0); PG8_STAGE(PG8_SA(0, 1), a2 + hstep, voffA);
            PG8_WAIT_L(8); PG8_BAR; PG8_WAIT_L(0); PG8_MMA(0, 0, At, B0); PG8_BAR; PG8_SCHED;
            PG8_LDB(B1, 1, 1); PG8_STAGE(PG8_SB(1, 0), b3, voffB);
            PG8_BAR; PG8_WAIT_L(0); PG8_MMA(0, 1, At, B1); PG8_BAR;
            PG8_LDA(At, 1, 1); PG8_STAGE(PG8_SA(1, 0), a3, voffA);
            PG8_BAR; PG8_WAIT_L(0); PG8_MMA(1, 0, At, B0); PG8_BAR; PG8_SCHED;
            PG8_STAGE(PG8_SB(1, 1), b3 + hstep, voffB);
            PG8_WAIT_V(6); PG8_BAR; PG8_MMA(1, 1, At, B1); PG8_BAR;
        }
        PG8_STAMP();
        if constexpr (!Epi::AFTER_DRAIN) { E(acc, cur, wr, wc, fr, fq); S.done(cur); }
        PG8_STAMP();
        if (!has_next) break;
#pragma unroll
        for (int a = 0; a < 2; ++a)
#pragma unroll
            for (int b = 0; b < 2; ++b)
#pragma unroll
                for (int m = 0; m < 4; ++m)
#pragma unroll
                    for (int n = 0; n < 2; ++n) acc[a][b][m][n] = (f32x4){0.f, 0.f, 0.f, 0.f};
        cur = nxt; cA = nA; cB = nB; ++ui;
    }
    PG8_WAIT_V(0);
    if (wr == 0) PG8_BAR;
    PG8_BAR;
    if constexpr (Epi::AFTER_DRAIN) { E.fused(acc, cur, wr, wc, fr, fq, lds, wid, lane); S.done(cur); }
    PG8_STAMP();
    if (STAMP && wid == 0) { stamps[lane] = lane < nts ? (((unsigned long long)(unsigned)ts_hi << 32) | (unsigned)ts_lo) : 0ull;
        if (lane == 62) stamps[62] = rt_entry; if (lane == 63) stamps[63] = (unsigned long long)wall_clock64(); }
#undef PG8_STAMP
#undef PG8_SA
#undef PG8_SB
#undef PG8_STAGE
#undef PG8_LDA
#undef PG8_LDB
#undef PG8_MMA
#undef PG8_WAIT_V
#undef PG8_WAIT_L
#undef PG8_BAR
#undef PG8_SCHED
}
}

using pg8::bf16_t; using pg8::bf16x8; using pg8::f32x4; using pg8::u32x4; using pg8::cvt_pk_bf16; using pg8::Unit;
#define LAS __attribute__((address_space(3)))
typedef unsigned u32x2 __attribute__((ext_vector_type(2)));
typedef short bf16x4 __attribute__((ext_vector_type(4)));

#ifndef PHASE_LIMIT
#define PHASE_LIMIT N_PHASES
#endif
#ifndef PHASE_MASK
#define PHASE_MASK 0x7ff
#endif
#define PHM(k) (((PHASE_MASK) >> (k)) & 1)
#ifndef N_LAUNCH_MODE
#define N_LAUNCH_MODE 0
#endif

constexpr int MT = 8192, DM = 2048, SEQ = 4096, NZ = 10240, NTR = 2048, FF = 8192, NWIN = 12288, WIN_LD = 12296;
constexpr int ZQA = 0, ZKA = 512, ZOA = 1024, ZQB = 1536, ZKB = 2560, ZUC = 3584, ZG = 4096;
constexpr int TVA = 0, TVB = 512, TVC = 1536;
constexpr int LDS_BYTES = 131072;
constexpr int N_PHASES = 1 + 9 * 2 + 1;

constexpr size_t al256(size_t x) { return (x + 255) & ~(size_t)255; }
constexpr size_t OFF_wt_in = 0;
constexpr size_t OFF_wt_a = OFF_wt_in + al256((size_t)2 * NWIN * 2048 * 2);
constexpr size_t OFF_wt_b = OFF_wt_a + al256((size_t)2 * 2048 * 512 * 2);
constexpr size_t OFF_wt_c = OFF_wt_b + al256((size_t)2 * 2048 * 1024 * 2);
constexpr size_t OFF_wt_out = OFF_wt_c + al256((size_t)2 * 2048 * 512 * 2);
constexpr size_t OFF_wt_up = OFF_wt_out + al256((size_t)2 * 2048 * 2048 * 2);
constexpr size_t OFF_wt_down = OFF_wt_up + al256((size_t)2 * 8192 * 2048 * 2);
constexpr size_t OFF_wt_pg = OFF_wt_down + al256((size_t)2 * 2048 * 8192 * 2);
constexpr size_t OFF_wt_pe = OFF_wt_pg + al256((size_t)2 * 2048 * 2048 * 2);
constexpr size_t OFF_gw = OFF_wt_pe + al256((size_t)2 * 2048 * 256 * 2);
constexpr size_t OFF_rope = OFF_gw + al256((size_t)2 * 2048 * 8 * 4);
constexpr size_t OFF_pb = OFF_rope + al256((size_t)SEQ * 16 * 2 * 4);
constexpr size_t OFF_xres = OFF_pb + al256((size_t)2 * MT * 256 * 2);
constexpr size_t OFF_xb0 = OFF_xres + al256((size_t)MT * DM * 4);
constexpr size_t OFF_xb1 = OFF_xb0 + al256((size_t)MT * DM * 2);
constexpr size_t OFF_ssq0 = OFF_xb1 + al256((size_t)MT * DM * 2);
constexpr size_t OFF_ssq1 = OFF_ssq0 + al256((size_t)MT * 32 * 4);
constexpr size_t OFF_Z = OFF_ssq1 + al256((size_t)MT * 32 * 4);
constexpr size_t OFF_ZT = OFF_Z + al256((size_t)MT * NZ * 2);
constexpr size_t OFF_GT = OFF_ZT + al256((size_t)NTR * MT * 2);
constexpr size_t OFF_dC = OFF_GT + al256((size_t)MT * 8 * 4);
constexpr size_t OFF_dn = OFF_dC + al256((size_t)8 * 64 * 16384 * 4);
constexpr size_t OFF_gsc = OFF_dn + al256((size_t)8 * 64 * 128 * 4);
constexpr size_t OFF_Cprev = OFF_gsc + al256((size_t)8 * 64 * 2 * 4);
constexpr size_t OFF_nprev = OFF_Cprev + al256((size_t)8 * 64 * 16384 * 2);
constexpr size_t OFF_mprev = OFF_nprev + al256((size_t)8 * 64 * 128 * 4);
constexpr size_t OFF_kmean = OFF_mprev + al256((size_t)8 * 64 * 4);
constexpr size_t OFF_yA = OFF_kmean + al256((size_t)16 * 16 * 128 * 4);
constexpr size_t OFF_yB = OFF_yA + al256((size_t)MT * 512 * 2);
constexpr size_t OFF_yC = OFF_yB + al256((size_t)MT * 1024 * 2);
constexpr size_t OFF_merged = OFF_xb0;
constexpr size_t OFF_mergedb = OFF_ZT;
constexpr size_t OFF_hidden = OFF_Z;
constexpr size_t OFF_pple = OFF_ZT;
constexpr size_t OFF_END = OFF_yC + al256((size_t)MT * 512 * 2);
struct Params { const float* in[21]; float* out; unsigned char* ws; int ph_lo, ph_hi; };

__device__ __forceinline__ int opq(int v) { asm volatile("" : "+v"(v)); return v; }
__device__ __forceinline__ float bf2f(bf16_t b) { return __uint_as_float(((unsigned)b) << 16); }
__device__ __forceinline__ float bflo(unsigned w) { return __uint_as_float(w << 16); }
__device__ __forceinline__ float bfhi(unsigned w) { return __uint_as_float(w & 0xffff0000u); }
__device__ __forceinline__ bf16_t f2bf(float f) { return (bf16_t)(cvt_pk_bf16(f, 0.f) & 0xffffu); }
__device__ __forceinline__ float ex2(float x) { return __builtin_amdgcn_exp2f(x); }
__device__ __forceinline__ float sigm(float x) { return __builtin_amdgcn_rcpf(1.f + ex2(-1.4426950408889634f * x)); }
__device__ __forceinline__ float gelu_t(float x) { const float u = 0.7978845608028654f * (x + 0.044715f * x * x * x); return x * sigm(2.f * u); }
__device__ __forceinline__ float wave_sum(float v) {
#pragma unroll
    for (int o = 32; o >= 1; o >>= 1) v += __shfl_xor(v, o);
    return v; }
__device__ __forceinline__ float wave_max(float v) {
#pragma unroll
    for (int o = 32; o >= 1; o >>= 1) v = fmaxf(v, __shfl_xor(v, o));
    return v; }
__device__ __forceinline__ float wave_scan_add(float v, int lane) {
#pragma unroll
    for (int o = 1; o < 64; o <<= 1) { const float t = __shfl_up(v, o); if (lane >= o) v += t; }
    return v; }
__device__ __forceinline__ float wave_scan_max(float v, int lane) {
#pragma unroll
    for (int o = 1; o < 64; o <<= 1) { const float t = __shfl_up(v, o); if (lane >= o) v = fmaxf(v, t); }
    return v; }
__device__ __forceinline__ f32x4 mfma16(bf16x8 a, bf16x8 b, f32x4 c) { return __builtin_amdgcn_mfma_f32_16x16x32_bf16(a, b, c, 0, 0, 0); }
__device__ __forceinline__ bf16x8 pack8(f32x4 a, f32x4 b) {
    u32x4 w; w.x = cvt_pk_bf16(a[0], a[1]); w.y = cvt_pk_bf16(a[2], a[3]); w.z = cvt_pk_bf16(b[0], b[1]); w.w = cvt_pk_bf16(b[2], b[3]);
    return __builtin_bit_cast(bf16x8, w); }
__device__ __forceinline__ bf16x8 cat4(bf16x4 a, bf16x4 b) { return __builtin_shufflevector(a, b, 0, 1, 2, 3, 4, 5, 6, 7); }
__device__ __forceinline__ u32x2 pack4(f32x4 a) { u32x2 w; w.x = cvt_pk_bf16(a[0], a[1]); w.y = cvt_pk_bf16(a[2], a[3]); return w; }
__device__ __forceinline__ f32x4 unpack4(u32x2 w) { return (f32x4){bflo(w.x), bfhi(w.x), bflo(w.y), bfhi(w.y)}; }
__device__ __forceinline__ float log_sigmoid(float x) { return fminf(x, 0.f) - log1pf(expf(-fabsf(x))); }

__device__ __forceinline__ float row_rstd(const float* ssq, int row, int fq) {
    const f32x4* q = (const f32x4*)(ssq + (size_t)row * 32 + fq * 8);
    const f32x4 a = q[0], b = q[1];
    float s = ((a[0] + a[1]) + (a[2] + a[3])) + ((b[0] + b[1]) + (b[2] + b[3]));
    s += __shfl_xor(s, 16); s += __shfl_xor(s, 32);
    return rsqrtf(s * (1.0f / 2048.0f) + 1e-6f);
}

struct EpiZ {
    static constexpr bool PERM = true, AFTER_DRAIN = false;
    bf16_t* Z; const float* ssq; const float* rope;
    __device__ __forceinline__ void operator()(const f32x4 (&acc)[2][2][4][2], const Unit& u, int wr, int wc, int fr, int fq) const {
        const int pn = u.pn;
        int mode = 0; float scl = 1.f;
        if (pn < 2) mode = 0; else if (pn < 4) scl = 0.08838834764831845f; else if (pn < 6) mode = 1; else if (pn < 14) mode = 2; else if (pn < 16) mode = 3; else mode = 1;
        const bool rot = (mode == 2) && (wc == 0);
        const float sg = (fq < 2) ? -1.f : 1.f;
        const int row0 = u.pm * 256 + wr * 64 + fr, col0 = pn * 256 + wc * 32 + 8 * fq;
#pragma unroll
        for (int ai = 0; ai < 2; ++ai)
#pragma unroll
            for (int m = 0; m < 4; ++m) {
                const int row = row0 + ai * 128 + m * 16;
                const float rs = row_rstd(ssq, row, fq) * scl;
                bf16_t* rowp = Z + (size_t)row * NZ + col0;
                f32x4 cs0 = {0.f, 0.f, 0.f, 0.f}, cs1 = cs0, cs2 = cs0, cs3 = cs0;
                if (rot) { const f32x4* rp = (const f32x4*)(rope + ((size_t)(row & (SEQ - 1)) * 16 + 8 * (fq & 1)) * 2); cs0 = rp[0]; cs1 = rp[1]; cs2 = rp[2]; cs3 = rp[3]; }
#pragma unroll
                for (int bj = 0; bj < 2; ++bj) {
                    f32x4 v0 = acc[ai][bj][m][0] * rs, v1 = acc[ai][bj][m][1] * rs;
                    if (mode == 1) {
#pragma unroll
                        for (int j = 0; j < 4; ++j) { v0[j] = sigm(v0[j]); v1[j] = sigm(v1[j]); } }
                    if (mode == 3) {
#pragma unroll
                        for (int j = 0; j < 4; ++j) { v0[j] = gelu_t(v0[j]); v1[j] = gelu_t(v1[j]); } }
                    if (rot) {
                        f32x4 p0, p1;
#pragma unroll
                        for (int j = 0; j < 4; ++j) { p0[j] = __shfl_xor(v0[j], 32); p1[j] = __shfl_xor(v1[j], 32); }
                        f32x4 o0, o1;
                        o0[0] = v0[0] * cs0[0] + sg * p0[0] * cs0[1]; o0[1] = v0[1] * cs0[2] + sg * p0[1] * cs0[3];
                        o0[2] = v0[2] * cs1[0] + sg * p0[2] * cs1[1]; o0[3] = v0[3] * cs1[2] + sg * p0[3] * cs1[3];
                        o1[0] = v1[0] * cs2[0] + sg * p1[0] * cs2[1]; o1[1] = v1[1] * cs2[2] + sg * p1[1] * cs2[3];
                        o1[2] = v1[2] * cs3[0] + sg * p1[2] * cs3[1]; o1[3] = v1[3] * cs3[2] + sg * p1[3] * cs3[3];
                        v0 = o0; v1 = o1;
                    }
                    *(bf16x8*)(rowp + bj * 128) = pack8(v0, v1);
                }
            }
    }
};
struct EpiZT {
    static constexpr bool PERM = true, AFTER_DRAIN = false;
    bf16_t* ZT; const float* ssq;
    __device__ __forceinline__ void operator()(const f32x4 (&acc)[2][2][4][2], const Unit& u, int wr, int wc, int fr, int fq) const {
        const bool gel = u.pm >= 6;
        const int lane = fq * 16 + fr;
        const int tokL = u.pn * 256 + 128 * (lane >> 5) + 32 * wc + (lane & 31);
        const f32x4* q = (const f32x4*)(ssq + (size_t)tokL * 32);
        float s = 0.f;
#pragma unroll
        for (int i = 0; i < 8; ++i) { const f32x4 a = q[i]; s += (a[0] + a[1]) + (a[2] + a[3]); }
        const float rsL = rsqrtf(s * (1.0f / 2048.0f) + 1e-6f);
        f32x4 rsv[2][2];
#pragma unroll
        for (int bj = 0; bj < 2; ++bj)
#pragma unroll
            for (int n = 0; n < 2; ++n)
#pragma unroll
                for (int i = 0; i < 4; ++i) rsv[bj][n][i] = __shfl(rsL, bj * 32 + 8 * fq + 4 * n + i);
        const int row0 = u.pm * 256 + wr * 64 + fr, col0 = u.pn * 256 + wc * 32 + 8 * fq;
#pragma unroll
        for (int ai = 0; ai < 2; ++ai)
#pragma unroll
            for (int m = 0; m < 4; ++m) {
                bf16_t* rowp = ZT + (size_t)(row0 + ai * 128 + m * 16) * MT + col0;
#pragma unroll
                for (int bj = 0; bj < 2; ++bj) {
                    f32x4 v0 = acc[ai][bj][m][0] * rsv[bj][0], v1 = acc[ai][bj][m][1] * rsv[bj][1];
                    if (gel) {
#pragma unroll
                        for (int j = 0; j < 4; ++j) { v0[j] = gelu_t(v0[j]); v1[j] = gelu_t(v1[j]); } }
                    *(bf16x8*)(rowp + bj * 128) = pack8(v0, v1);
                }
            }
    }
};
template <int BR> struct EpiBr {
    static constexpr bool PERM = false, AFTER_DRAIN = false;
    const bf16_t* Z; float* merged; bf16_t* mergedb;
    __device__ __forceinline__ void operator()(const f32x4 (&acc)[2][2][4][2], const Unit& u, int wr, int wc, int fr, int fq) const {
        const int row0 = u.pm * 256 + wr * 64 + fr, col0 = u.pn * 256 + wc * 32 + 4 * fq;
#pragma unroll
        for (int ai = 0; ai < 2; ++ai)
#pragma unroll
            for (int m = 0; m < 4; ++m) {
                const int row = row0 + ai * 128 + m * 16;
#pragma unroll
                for (int bj = 0; bj < 2; ++bj)
#pragma unroll
                    for (int n = 0; n < 2; ++n) {
                        const int c = col0 + bj * 128 + n * 16;
                        const u32x2 g = *(const u32x2*)(Z + (size_t)row * NZ + ZG + BR * 2048 + c);
                        const f32x4 v = acc[ai][bj][m][n] * unpack4(g);
                        float* mp = merged + (size_t)row * DM + c;
                        if (BR == 0) *(f32x4*)mp = v;
                        else if (BR == 1) *(f32x4*)mp = *(const f32x4*)mp + v;
                        else *(u32x2*)(mergedb + (size_t)row * DM + c) = pack4(*(const f32x4*)mp + v);
                    }
            }
    }
};
template <int MODE> struct EpiRes {
    static constexpr bool PERM = false, AFTER_DRAIN = false;
    const float* base; float* out; bf16_t* xb; float* ssq_out; const float* ssq_in; const bf16_t* P;
    __device__ __forceinline__ void operator()(const f32x4 (&acc)[2][2][4][2], const Unit& u, int wr, int wc, int fr, int fq) const {
        const int row0 = u.pm * 256 + wr * 64 + fr, col0 = u.pn * 256 + wc * 32 + 4 * fq;
#pragma unroll
        for (int ai = 0; ai < 2; ++ai)
#pragma unroll
            for (int m = 0; m < 4; ++m) {
                const int row = row0 + ai * 128 + m * 16;
                float rs = 0.f; if (MODE == 1) rs = row_rstd(ssq_in, row, fq);
                float ss = 0.f;
#pragma unroll
                for (int bj = 0; bj < 2; ++bj)
#pragma unroll
                    for (int n = 0; n < 2; ++n) {
                        const size_t off = (size_t)row * DM + col0 + bj * 128 + n * 16;
                        f32x4 d = acc[ai][bj][m][n];
                        if (MODE == 1) { const f32x4 pp = unpack4(*(const u32x2*)(P + off));
#pragma unroll
                            for (int j = 0; j < 4; ++j) d[j] = sigm(d[j] * rs) * pp[j]; }
                        const f32x4 xn = *(const f32x4*)(base + off) + d;
                        *(f32x4*)(out + off) = xn;
                        *(u32x2*)(xb + off) = pack4(xn);
                        ss += (xn[0] * xn[0] + xn[1] * xn[1]) + (xn[2] * xn[2] + xn[3] * xn[3]);
                    }
                ss += __shfl_xor(ss, 16); ss += __shfl_xor(ss, 32);
                if (fq == 0) ssq_out[(size_t)row * 32 + u.pn * 4 + wc] = ss;
            }
    }
};
struct EpiUp {
    static constexpr bool PERM = true, AFTER_DRAIN = false;
    bf16_t* H; const float* ssq;
    __device__ __forceinline__ void operator()(const f32x4 (&acc)[2][2][4][2], const Unit& u, int wr, int wc, int fr, int fq) const {
        const int row0 = u.pm * 256 + wr * 64 + fr, col0 = u.pn * 256 + wc * 32 + 8 * fq;
#pragma unroll
        for (int ai = 0; ai < 2; ++ai)
#pragma unroll
            for (int m = 0; m < 4; ++m) {
                const int row = row0 + ai * 128 + m * 16;
                const float rs = row_rstd(ssq, row, fq);
                bf16_t* rowp = H + (size_t)row * FF + col0;
#pragma unroll
                for (int bj = 0; bj < 2; ++bj) {
                    f32x4 v0 = acc[ai][bj][m][0] * rs, v1 = acc[ai][bj][m][1] * rs;
#pragma unroll
                    for (int j = 0; j < 4; ++j) { const float a = fmaxf(v0[j], 0.f), b = fmaxf(v1[j], 0.f); v0[j] = a * a; v1[j] = b * b; }
                    *(bf16x8*)(rowp + bj * 128) = pack8(v0, v1);
                }
            }
    }
};
struct EpiP {
    static constexpr bool PERM = true, AFTER_DRAIN = false;
    bf16_t* O; int ldc;
    __device__ __forceinline__ void operator()(const f32x4 (&acc)[2][2][4][2], const Unit& u, int wr, int wc, int fr, int fq) const {
        const int row0 = u.pm * 256 + wr * 64 + fr, col0 = u.pn * 256 + wc * 32 + 8 * fq;
#pragma unroll
        for (int ai = 0; ai < 2; ++ai)
#pragma unroll
            for (int m = 0; m < 4; ++m) {
                bf16_t* rowp = O + (size_t)(row0 + ai * 128 + m * 16) * ldc + col0;
#pragma unroll
                for (int bj = 0; bj < 2; ++bj) *(bf16x8*)(rowp + bj * 128) = pack8(acc[ai][bj][m][0], acc[ai][bj][m][1]);
            }
    }
};

template <class Epi> __device__ __forceinline__ void run_gemm(LAS unsigned char* lds, const bf16_t* A, const bf16_t* Bt, int M, int N, int K, const Epi& E) {
    __syncthreads();
    pg8::Gemm g{A, Bt, M, N, K}; pg8::StaticOrder S; S.init(M, N, (int)gridDim.x, (int)blockIdx.x);
    pg8::gemm_phase<Epi, pg8::StaticOrder, false>(lds, g, S, E, nullptr);
    __syncthreads();
}

__device__ __forceinline__ void cvt_tile(LAS float* tile, const float* src, int ld, const float* gain, bf16_t* dst, int K, int kt, int nt, int tid) {
    const int k0 = kt * 64, n0 = nt * 64;
#pragma unroll
    for (int i = 0; i < 8; ++i) { const int k = (tid >> 6) + 8 * i, n = tid & 63; float v = src[(size_t)(k0 + k) * ld + n0 + n]; if (gain) v *= gain[k0 + k]; tile[k * 65 + n] = v; }
    __syncthreads();
    { const int n = tid >> 3, kc = (tid & 7) * 8; f32x4 a, b;
#pragma unroll
      for (int e = 0; e < 4; ++e) { a[e] = tile[(kc + e) * 65 + n]; b[e] = tile[(kc + 4 + e) * 65 + n]; }
      *(bf16x8*)(dst + (size_t)(n0 + n) * K + k0 + kc) = pack8(a, b); }
    __syncthreads();
}
__device__ __forceinline__ void cvt_seg(LAS float* tile, const float* src, int ld, const float* gain, bf16_t* dst, int K, int N, int tid) {
    const int nkt = K / 64, ntiles = nkt * (N / 64);
    for (int t = blockIdx.x; t < ntiles; t += gridDim.x) cvt_tile(tile, src, ld, gain, dst, K, t % nkt, t / nkt, tid);
}
__device__ void prologue(const Params& p, LAS unsigned char* lds, int tid) {
    LAS float* tile = (LAS float*)lds;
    const int gid = blockIdx.x * 512 + tid, gsz = gridDim.x * 512;
    for (int i = gid; i < SEQ * 16; i += gsz) {
        const int pos = i >> 4, j = i & 15;
        const float inv = exp2f(-(float)j * (1.0f / 16.0f) * 18.931568569324174f);
        const float ang = (float)pos * inv;
        const double rev = (double)ang * 0.15915494309189535;
        const float fr = (float)(rev - floor(rev));
        ((float*)(p.ws + OFF_rope))[2 * i] = __builtin_amdgcn_cosf(fr); ((float*)(p.ws + OFF_rope))[2 * i + 1] = __builtin_amdgcn_sinf(fr);
    }
    for (int i = gid; i < 2 * 2048 * 8; i += gsz) { const int l = i >> 14, k = (i >> 3) & 2047, j = i & 7; ((float*)(p.ws + OFF_gw))[i] = p.in[3][((size_t)l * 2048 + k) * WIN_LD + 2048 + j] * p.in[2][l * 2048 + k]; }
    for (int i = gid; i < 2 * MT * 256 / 4; i += gsz) { const f32x4 v = ((const f32x4*)p.in[1])[i]; ((u32x2*)((bf16_t*)(p.ws + OFF_pb)))[i] = pack4(v); }
    { const int lane = tid & 63, w = tid >> 6;
      for (int row = blockIdx.x * 8 + w; row < MT; row += gridDim.x * 8) {
          float ss = 0.f;
#pragma unroll
          for (int i = 0; i < 8; ++i) { const int k = 4 * lane + 256 * i; const f32x4 v = *(const f32x4*)(p.in[0] + (size_t)row * DM + k); ss += (v[0] * v[0] + v[1] * v[1]) + (v[2] * v[2] + v[3] * v[3]); *(u32x2*)(((bf16_t*)(p.ws + OFF_xb0)) + (size_t)row * DM + k) = pack4(v); }
          ss = wave_sum(ss);
          if (lane < 32) ((float*)(p.ws + OFF_ssq0))[(size_t)row * 32 + lane] = lane == 0 ? ss : 0.f;
      } }
    for (int l = 0; l < 2; ++l) {
        const float* win = p.in[3] + (size_t)l * 2048 * WIN_LD; bf16_t* wti = ((bf16_t*)(p.ws + OFF_wt_in)) + (size_t)l * NWIN * 2048; const float* gm = p.in[2] + l * 2048;
        cvt_seg(tile, win + 0,    WIN_LD, gm, wti + (size_t)0 * 2048,     2048, 512, tid);
        cvt_seg(tile, win + 512,  WIN_LD, gm, wti + (size_t)512 * 2048,   2048, 512, tid);
        cvt_seg(tile, win + 1536, WIN_LD, gm, wti + (size_t)1024 * 2048,  2048, 512, tid);
        cvt_seg(tile, win + 2056, WIN_LD, gm, wti + (size_t)1536 * 2048,  2048, 1024, tid);
        cvt_seg(tile, win + 3080, WIN_LD, gm, wti + (size_t)2560 * 2048,  2048, 1024, tid);
        cvt_seg(tile, win + 5128, WIN_LD, gm, wti + (size_t)3584 * 2048,  2048, 512, tid);
        cvt_seg(tile, win + 6152, WIN_LD, gm, wti + (size_t)4096 * 2048,  2048, 6144, tid);
        cvt_seg(tile, win + 1024, WIN_LD, gm, wti + (size_t)10240 * 2048, 2048, 512, tid);
        cvt_seg(tile, win + 4104, WIN_LD, gm, wti + (size_t)10752 * 2048, 2048, 1024, tid);
        cvt_seg(tile, win + 5640, WIN_LD, gm, wti + (size_t)11776 * 2048, 2048, 512, tid);
        cvt_seg(tile, p.in[10] + (size_t)l * 512 * 2048,   2048, nullptr, ((bf16_t*)(p.ws + OFF_wt_a)) + (size_t)l * 2048 * 512,   512, 2048, tid);
        cvt_seg(tile, p.in[11] + (size_t)l * 1024 * 2048,  2048, nullptr, ((bf16_t*)(p.ws + OFF_wt_b)) + (size_t)l * 2048 * 1024,  1024, 2048, tid);
        cvt_seg(tile, p.in[12] + (size_t)l * 512 * 2048,   2048, nullptr, ((bf16_t*)(p.ws + OFF_wt_c)) + (size_t)l * 2048 * 512,   512, 2048, tid);
        cvt_seg(tile, p.in[13] + (size_t)l * 2048 * 2048, 2048, nullptr, ((bf16_t*)(p.ws + OFF_wt_out)) + (size_t)l * 2048 * 2048, 2048, 2048, tid);
        cvt_seg(tile, p.in[15] + (size_t)l * 2048 * 8192, 8192, p.in[14] + l * 2048, ((bf16_t*)(p.ws + OFF_wt_up)) + (size_t)l * 8192 * 2048, 2048, 8192, tid);
        cvt_seg(tile, p.in[16] + (size_t)l * 8192 * 2048, 2048, nullptr, ((bf16_t*)(p.ws + OFF_wt_down)) + (size_t)l * 2048 * 8192, 8192, 2048, tid);
        cvt_seg(tile, p.in[18] + (size_t)l * 2048 * 2048, 2048, p.in[17] + l * 2048, ((bf16_t*)(p.ws + OFF_wt_pg)) + (size_t)l * 2048 * 2048, 2048, 2048, tid);
        cvt_seg(tile, p.in[19] + (size_t)l * 256 * 2048,  2048, nullptr, ((bf16_t*)(p.ws + OFF_wt_pe)) + (size_t)l * 2048 * 256,  256, 2048, tid);
    }
}

__device__ void gates_phase(const Params& p, int layer, const float* xsrc, int tid) {
    const int lane = tid & 63, w = tid >> 6;
    const float* gwt = ((float*)(p.ws + OFF_gw)) + (size_t)layer * 2048 * 8;
    for (int r0 = blockIdx.x * 8 + w; r0 < 2048; r0 += gridDim.x * 8) {
        float acc[4][8]; float ss[4];
#pragma unroll
        for (int i = 0; i < 4; ++i) { ss[i] = 0.f;
#pragma unroll
            for (int j = 0; j < 8; ++j) acc[i][j] = 0.f; }
        for (int kk = 0; kk < 8; ++kk) {
            const int k = 4 * lane + 256 * kk;
            f32x4 xv[4];
#pragma unroll
            for (int i = 0; i < 4; ++i) { xv[i] = *(const f32x4*)(xsrc + (size_t)(r0 + 2048 * i) * DM + k); ss[i] += (xv[i][0] * xv[i][0] + xv[i][1] * xv[i][1]) + (xv[i][2] * xv[i][2] + xv[i][3] * xv[i][3]); }
#pragma unroll
            for (int kq = 0; kq < 4; ++kq) {
                const f32x4 w0 = *(const f32x4*)(gwt + (size_t)(k + kq) * 8), w1 = *(const f32x4*)(gwt + (size_t)(k + kq) * 8 + 4);
#pragma unroll
                for (int i = 0; i < 4; ++i) { const float xx = xv[i][kq];
#pragma unroll
                    for (int j = 0; j < 4; ++j) { acc[i][j] += xx * w0[j]; acc[i][4 + j] += xx * w1[j]; } }
            }
        }
#pragma unroll
        for (int i = 0; i < 4; ++i) {
            const float rs = rsqrtf(wave_sum(ss[i]) * (1.0f / 2048.0f) + 1e-6f);
            float outv = 0.f;
#pragma unroll
            for (int j = 0; j < 8; ++j) { const float v = wave_sum(acc[i][j]); if (lane == j) outv = v * rs + p.in[4][layer * 8 + j]; }
            if (lane < 8) ((float*)(p.ws + OFF_GT))[(size_t)(r0 + 2048 * i) * 8 + lane] = outv;
        }
    }
}

__device__ void mlstm_a_unit(const Params& p, LAS unsigned char* lds, int unit, int tid) {
    const int bh = unit >> 6, c = unit & 63, b = bh >> 2, h = bh & 3;
    const int tok0 = b * SEQ + c * 64;
    const int lane = tid & 63, w = tid >> 6, fr = lane & 15, g4 = lane >> 4;
    LAS bf16_t* KT = (LAS bf16_t*)lds;
    const float ig = ((float*)(p.ws + OFF_GT))[(size_t)(tok0 + lane) * 8 + h], fp = ((float*)(p.ws + OFF_GT))[(size_t)(tok0 + lane) * 8 + 4 + h];
    const float g = wave_scan_add(log_sigmoid(fp), lane);
    const float glast = __shfl(g, 63);
    const float lu = glast - g + ig;
    const float mloc = wave_max(lu);
    const float uu = expf(lu - mloc);
    { const int l = tid >> 3, kc = (tid & 7) * 16;
      const float ul = __shfl(uu, l);
      const u32x4* src = (const u32x4*)(((bf16_t*)(p.ws + OFF_Z)) + (size_t)(tok0 + l) * NZ + ZKA + h * 128 + kc);
      const u32x4 a = src[0], bq = src[1];
      const unsigned wd[8] = {a.x, a.y, a.z, a.w, bq.x, bq.y, bq.z, bq.w};
#pragma unroll
      for (int e = 0; e < 8; ++e) { KT[(kc + 2 * e) * 72 + l] = f2bf(bflo(wd[e]) * ul); KT[(kc + 2 * e + 1) * 72 + l] = f2bf(bfhi(wd[e]) * ul); } }
    __syncthreads();
    if (tid < 128) {
        float s = 0.f; const LAS bf16x8* r = (const LAS bf16x8*)(KT + tid * 72);
#pragma unroll
        for (int i = 0; i < 8; ++i) { const bf16x8 v = r[i];
#pragma unroll
            for (int e = 0; e < 8; ++e) s += bf2f((bf16_t)v[e]); }
        ((float*)(p.ws + OFF_dn))[((size_t)bh * 64 + c) * 128 + tid] = s;
    }
    f32x4 acc[8];
#pragma unroll
    for (int kt = 0; kt < 8; ++kt) acc[kt] = (f32x4){0.f, 0.f, 0.f, 0.f};
    const bf16_t* vt = ((bf16_t*)(p.ws + OFF_ZT)) + (size_t)(TVA + h * 128 + 16 * w + fr) * MT + tok0 + 8 * g4;
    const bf16x8 A0 = *(const bf16x8*)vt, A1 = *(const bf16x8*)(vt + 32);
#pragma unroll
    for (int kt = 0; kt < 8; ++kt) {
        const LAS bf16_t* kb = KT + (16 * kt + fr) * 72 + 8 * g4;
        const bf16x8 B0 = *(const LAS bf16x8*)kb, B1 = *(const LAS bf16x8*)(kb + 32);
        acc[kt] = mfma16(A0, B0, acc[kt]); acc[kt] = mfma16(A1, B1, acc[kt]);
    }
    float* dst = ((float*)(p.ws + OFF_dC)) + ((size_t)bh * 64 + c) * 16384;
#pragma unroll
    for (int kt = 0; kt < 8; ++kt)
#pragma unroll
        for (int j = 0; j < 4; ++j) dst[(16 * w + 4 * g4 + j) * 128 + 16 * kt + fr] = acc[kt][j];
    if (tid == 0) { ((float*)(p.ws + OFF_gsc))[(bh * 64 + c) * 2] = glast; ((float*)(p.ws + OFF_gsc))[(bh * 64 + c) * 2 + 1] = mloc; }
    __syncthreads();
}
__device__ void mlstm_scan(const Params& p, int tid) {
    const int total = 8 * 16512;
    for (int e = blockIdx.x * 512 + tid; e < total; e += gridDim.x * 512) {
        const int bh = e / 16512, r = e - bh * 16512;
        const bool isC = r < 16384;
        const float* src = isC ? ((float*)(p.ws + OFF_dC)) + (size_t)bh * 64 * 16384 + r : ((float*)(p.ws + OFF_dn)) + (size_t)bh * 64 * 128 + (r - 16384);
        const int stride = isC ? 16384 : 128;
        float st = 0.f, m = 0.f;
#pragma unroll 8
        for (int c = 0; c < 64; ++c) {
            if (isC) ((bf16_t*)(p.ws + OFF_Cprev))[((size_t)bh * 64 + c) * 16384 + r] = f2bf(st); else ((float*)(p.ws + OFF_nprev))[((size_t)bh * 64 + c) * 128 + (r - 16384)] = st;
            if (r == 0) ((float*)(p.ws + OFF_mprev))[bh * 64 + c] = m;
            const float gl = ((float*)(p.ws + OFF_gsc))[(bh * 64 + c) * 2], ml = ((float*)(p.ws + OFF_gsc))[(bh * 64 + c) * 2 + 1];
            const float mn = fmaxf(gl + m, ml);
            st = expf(gl + m - mn) * st + expf(ml - mn) * src[(size_t)c * stride];
            m = mn;
        }
    }
}
__device__ void mlstm_c_unit(const Params& p, LAS unsigned char* lds, int unit, int tid, int layer) {
    const int bh = unit >> 6, c = unit & 63, b = bh >> 2, h = bh & 3;
    const int tok0 = b * SEQ + c * 64;
    const int lane = tid & 63, w = tid >> 6, fr = lane & 15, g4 = lane >> 4;
    LAS float* sE = (LAS float*)lds; LAS float* sD = sE + 64; LAS float* sMr = sE + 128; LAS float* sSS = sE + 192;
    const float m0 = ((float*)(p.ws + OFF_mprev))[bh * 64 + c];
    if (w == 0) {
        const float ig = ((float*)(p.ws + OFF_GT))[(size_t)(tok0 + lane) * 8 + h], fp = ((float*)(p.ws + OFF_GT))[(size_t)(tok0 + lane) * 8 + 4 + h];
        const float g = wave_scan_add(log_sigmoid(fp), lane);
        const float d = ig - g;
        const float bm = wave_scan_max(d, lane);
        const float mrow = g + fmaxf(bm, m0);
        sE[lane] = g - mrow; sD[lane] = d; sMr[lane] = mrow;
    }
    __syncthreads();
    const int lt = w & 3, vh = w >> 2;
    const int l = 16 * lt + fr;
    const bf16_t* qp = ((bf16_t*)(p.ws + OFF_Z)) + (size_t)(tok0 + l) * NZ + ZQA + h * 128 + 8 * g4;
    bf16x8 Q[4];
#pragma unroll
    for (int ks = 0; ks < 4; ++ks) Q[ks] = *(const bf16x8*)(qp + 32 * ks);
    const float el = sE[l];
    f32x4 pv[4]; float dsum = 0.f;
#pragma unroll
    for (int st = 0; st < 4; ++st) {
        pv[st] = (f32x4){0.f, 0.f, 0.f, 0.f};
        if (st <= lt) {
            const bf16_t* kp = ((bf16_t*)(p.ws + OFF_Z)) + (size_t)(tok0 + 16 * st + fr) * NZ + ZKA + h * 128 + 8 * g4;
            f32x4 s = {0.f, 0.f, 0.f, 0.f};
#pragma unroll
            for (int ks = 0; ks < 4; ++ks) s = mfma16(*(const bf16x8*)(kp + 32 * ks), Q[ks], s);
#pragma unroll
            for (int j = 0; j < 4; ++j) { const int sidx = 16 * st + 4 * g4 + j; const float wgt = (sidx <= l) ? s[j] * expf(el + sD[sidx]) : 0.f; pv[st][j] = wgt; dsum += wgt; }
        }
    }
    dsum += __shfl_xor(dsum, 16); dsum += __shfl_xor(dsum, 32);
    bf16x8 PB[2]; PB[0] = pack8(pv[0], pv[1]); PB[1] = pack8(pv[2], pv[3]);
    float qn = 0.f;
    { const float* np = ((float*)(p.ws + OFF_nprev)) + ((size_t)bh * 64 + c) * 128 + 8 * g4;
#pragma unroll
      for (int ks = 0; ks < 4; ++ks) { const f32x4 n0 = *(const f32x4*)(np + 32 * ks), n1 = *(const f32x4*)(np + 32 * ks + 4);
#pragma unroll
          for (int e = 0; e < 4; ++e) { qn += n0[e] * bf2f((bf16_t)Q[ks][e]); qn += n1[e] * bf2f((bf16_t)Q[ks][4 + e]); } } }
    qn += __shfl_xor(qn, 16); qn += __shfl_xor(qn, 32);
    const float al = expf(el + m0);
    const float den = dsum + al * qn;
    const float inv = 1.0f / fmaxf(fabsf(den), expf(-sMr[l]));
    f32x4 hv[4]; float ss = 0.f;
    const bf16_t* cp = ((bf16_t*)(p.ws + OFF_Cprev)) + ((size_t)bh * 64 + c) * 16384;
#pragma unroll
    for (int vt = 0; vt < 4; ++vt) {
        const int vrow = 64 * vh + 16 * vt + fr;
        f32x4 nacc = {0.f, 0.f, 0.f, 0.f}, iacc = {0.f, 0.f, 0.f, 0.f};
        const bf16_t* vp = ((bf16_t*)(p.ws + OFF_ZT)) + (size_t)(TVA + h * 128 + vrow) * MT + tok0 + 4 * g4;
#pragma unroll
        for (int kk = 0; kk < 2; ++kk) if (2 * kk <= lt) { const bf16x4 a0 = *(const bf16x4*)(vp + 32 * kk), a1 = *(const bf16x4*)(vp + 32 * kk + 16); nacc = mfma16(cat4(a0, a1), PB[kk], nacc); }
        const bf16_t* cr = cp + (size_t)vrow * 128 + 8 * g4;
#pragma unroll
        for (int ks = 0; ks < 4; ++ks) iacc = mfma16(*(const bf16x8*)(cr + 32 * ks), Q[ks], iacc);
#pragma unroll
        for (int j = 0; j < 4; ++j) { const float hh = (nacc[j] + al * iacc[j]) * inv; hv[vt][j] = hh; ss += hh * hh; }
    }
    ss += __shfl_xor(ss, 16); ss += __shfl_xor(ss, 32);
    if (g4 == 0) sSS[w * 16 + fr] = ss;
    __syncthreads();
    const float tot = ss + sSS[(w ^ 4) * 16 + fr];
    const float rn = rsqrtf(tot * (1.0f / 128.0f) + 1e-6f);
#pragma unroll
    for (int vt = 0; vt < 4; ++vt) {
        const int v0 = 64 * vh + 16 * vt + 4 * g4;
        const f32x4 ng = *(const f32x4*)(p.in[5] + layer * 512 + h * 128 + v0);
        const f32x4 so = unpack4(*(const u32x2*)(((bf16_t*)(p.ws + OFF_Z)) + (size_t)(tok0 + l) * NZ + ZOA + h * 128 + v0));
        f32x4 y;
#pragma unroll
        for (int j = 0; j < 4; ++j) y[j] = hv[vt][j] * rn * ng[j] * so[j];
        *(u32x2*)(((bf16_t*)(p.ws + OFF_yA)) + (size_t)(tok0 + l) * 512 + h * 128 + v0) = pack4(y);
    }
    __syncthreads();
}

__device__ void kmean_unit(const Params& p, LAS unsigned char* lds, int unit, int tid) {
    const int bh = unit >> 4, j = unit & 15, b = bh >> 3, h = bh & 7;
    LAS float* red = (LAS float*)lds;
    const int dc = tid & 15, kg = tid >> 4;
    float a[8];
#pragma unroll
    for (int e = 0; e < 8; ++e) a[e] = 0.f;
    const bf16_t* src = ((bf16_t*)(p.ws + OFF_Z)) + (size_t)(b * SEQ + j * 256 + kg * 8) * NZ + ZKB + h * 128 + dc * 8;
#pragma unroll
    for (int i = 0; i < 8; ++i) { const u32x4 v = *(const u32x4*)(src + (size_t)i * NZ);
        a[0] += bflo(v.x); a[1] += bfhi(v.x); a[2] += bflo(v.y); a[3] += bfhi(v.y); a[4] += bflo(v.z); a[5] += bfhi(v.z); a[6] += bflo(v.w); a[7] += bfhi(v.w); }
#pragma unroll
    for (int e = 0; e < 8; ++e) red[kg * 128 + dc * 8 + e] = a[e];
    __syncthreads();
    if (tid < 128) { float s = 0.f;
#pragma unroll 8
        for (int g = 0; g < 32; ++g) s += red[g * 128 + tid];
        ((float*)(p.ws + OFF_kmean))[((size_t)bh * 16 + j) * 128 + tid] = s * (1.0f / 256.0f); }
    __syncthreads();
}
constexpr float MOBA_SC = 0.08838834764831845f * 1.4426950408889634f;
__device__ void moba_unit(const Params& p, LAS unsigned char* lds, int unit, int tid) {
    const int bh = unit >> 4, pi = unit & 15, b = bh >> 3, h = bh & 7;
    const int lane = tid & 63, w = tid >> 6, fr = lane & 15, g4 = lane >> 4;
    LAS float* sKm = (LAS float*)lds;
    LAS unsigned* sSel = (LAS unsigned*)(lds + 8448);
    LAS bf16_t* Ks0 = (LAS bf16_t*)(lds + 9216);
    for (int i = tid; i < 2048; i += 512) sKm[(i >> 7) * 132 + (i & 127)] = ((float*)(p.ws + OFF_kmean))[(size_t)bh * 2048 + i];
    for (int half = 0; half < 2; ++half) {
        const int tile = half ? 31 - pi : pi; const int ib = tile >> 1;
        const int qtok0 = b * SEQ + tile * 128;
        __syncthreads();
        {
            const int row = tid >> 2, jq = tid & 3;
            const bf16_t* qp = ((bf16_t*)(p.ws + OFF_Z)) + (size_t)(qtok0 + row) * NZ + ZQB + h * 128;
            float sc4[4] = {0.f, 0.f, 0.f, 0.f};
            for (int d8 = 0; d8 < 16; ++d8) {
                const u32x4 qv = *(const u32x4*)(qp + 8 * d8);
                const f32x4 q0 = {bflo(qv.x), bfhi(qv.x), bflo(qv.y), bfhi(qv.y)}, q1 = {bflo(qv.z), bfhi(qv.z), bflo(qv.w), bfhi(qv.w)};
#pragma unroll
                for (int m = 0; m < 4; ++m) { const LAS float* km = sKm + (4 * m + jq) * 132 + 8 * d8; const f32x4 k0 = *(const LAS f32x4*)km, k1 = *(const LAS f32x4*)(km + 4);
                    sc4[m] += (q0[0] * k0[0] + q0[1] * k0[1]) + (q0[2] * k0[2] + q0[3] * k0[3]) + (q1[0] * k1[0] + q1[1] * k1[1]) + (q1[2] * k1[2] + q1[3] * k1[3]); }
            }
            float sc[16];
#pragma unroll
            for (int m = 0; m < 4; ++m)
#pragma unroll
                for (int qq = 0; qq < 4; ++qq) sc[4 * m + qq] = __shfl(sc4[m], (lane & ~3) | qq);
            unsigned mask = 0;
#pragma unroll
            for (int r = 0; r < 3; ++r) { float best = -3.0e38f; int bi = -1;
#pragma unroll
                for (int j = 0; j < 16; ++j) if (j < ib && !((mask >> j) & 1u) && sc[j] > best) { best = sc[j]; bi = j; }
                if (bi >= 0) mask |= 1u << bi; }
            if (jq == 0) sSel[row] = mask;
        }
        __syncthreads();
        const int myrow = 16 * w + fr;
        const unsigned mk = sSel[myrow];
        const int qpos = tile * 128 + myrow;
        bf16x8 Q[4];
        { const bf16_t* qp = ((bf16_t*)(p.ws + OFF_Z)) + (size_t)(qtok0 + myrow) * NZ + ZQB + h * 128 + 8 * g4;
#pragma unroll
          for (int ks = 0; ks < 4; ++ks) Q[ks] = *(const bf16x8*)(qp + 32 * ks); }
        f32x4 O[8];
#pragma unroll
        for (int dt = 0; dt < 8; ++dt) O[dt] = (f32x4){0.f, 0.f, 0.f, 0.f};
        float mrun = -1.0e30f, lrun = 0.f;
        const int ntile = (ib + 1) * 4;
        const int krow = tid >> 3, kc = tid & 7, vrow = tid >> 2, vc = tid & 3;
        const bf16_t* kg = ((bf16_t*)(p.ws + OFF_Z)) + (size_t)(b * SEQ + krow) * NZ + ZKB + h * 128 + kc * 8;
        const bf16_t* vg = ((bf16_t*)(p.ws + OFF_ZT)) + (size_t)(TVB + h * 128 + vrow) * MT + b * SEQ + vc * 8;
        u32x4 rk0, rk1, rv0, rv1;
#define MOBA_LOAD(kt) do { const bf16_t* kq_ = kg + (size_t)(kt) * 64 * NZ; rk0 = *(const u32x4*)kq_; rk1 = *(const u32x4*)(kq_ + 64); const bf16_t* vq_ = vg + (kt) * 64; rv0 = *(const u32x4*)vq_; rv1 = *(const u32x4*)(vq_ + 32); } while (0)
#define MOBA_STORE(buf) do { LAS bf16_t* kb_ = Ks0 + (buf) * 17920; LAS bf16_t* vb_ = kb_ + 8704; *(LAS u32x4*)(kb_ + krow * 136 + kc * 8) = rk0; *(LAS u32x4*)(kb_ + krow * 136 + kc * 8 + 64) = rk1; \
        *(LAS u32x4*)(vb_ + vrow * 72 + vc * 8) = rv0; *(LAS u32x4*)(vb_ + vrow * 72 + vc * 8 + 32) = rv1; } while (0)
        MOBA_LOAD(0); MOBA_STORE(0); __syncthreads();
        for (int kt = 0; kt < ntile; ++kt) {
            const int cur = kt & 1;
            if (kt + 1 < ntile) MOBA_LOAD(kt + 1);
            const int jb = kt >> 2, key0 = kt * 64;
            const bool past = jb < ib;
            const bool lane_ok = past ? (((mk >> jb) & 1u) != 0u) : true;
            const bool need = past ? (__any(lane_ok ? 1 : 0) != 0) : (key0 <= tile * 128 + 16 * w + 15);
            if (need) {
                const LAS bf16_t* Kc = Ks0 + cur * 17920; const LAS bf16_t* Vc = Kc + 8704;
                f32x4 S[4];
#pragma unroll
                for (int st = 0; st < 4; ++st) { S[st] = (f32x4){0.f, 0.f, 0.f, 0.f}; const LAS bf16_t* kp = Kc + (16 * st + fr) * 136 + 8 * g4;
#pragma unroll
                    for (int ks = 0; ks < 4; ++ks) S[st] = mfma16(*(const LAS bf16x8*)(kp + 32 * ks), Q[ks], S[st]); }
                float mx = -1.0e30f;
#pragma unroll
                for (int st = 0; st < 4; ++st)
#pragma unroll
                    for (int j = 0; j < 4; ++j) { const int key = key0 + 16 * st + 4 * g4 + j; const bool a = past ? lane_ok : (key <= qpos); const float sv = a ? S[st][j] * MOBA_SC : -1.0e30f; S[st][j] = sv; mx = fmaxf(mx, sv); }
                mx = fmaxf(mx, __shfl_xor(mx, 16)); mx = fmaxf(mx, __shfl_xor(mx, 32));
                const float mnew = fmaxf(mrun, mx);
                const float alpha = ex2(mrun - mnew);
                float psum = 0.f;
#pragma unroll
                for (int st = 0; st < 4; ++st)
#pragma unroll
                    for (int j = 0; j < 4; ++j) { const float pe = (S[st][j] > -1.0e29f) ? ex2(S[st][j] - mnew) : 0.f; S[st][j] = pe; psum += pe; }
                lrun = lrun * alpha + psum; mrun = mnew;
#pragma unroll
                for (int dt = 0; dt < 8; ++dt) O[dt] *= alpha;
                bf16x8 PB[2]; PB[0] = pack8(S[0], S[1]); PB[1] = pack8(S[2], S[3]);
#pragma unroll
                for (int dt = 0; dt < 8; ++dt) { const LAS bf16_t* vp = Vc + (16 * dt + fr) * 72 + 4 * g4;
#pragma unroll
                    for (int kk = 0; kk < 2; ++kk) { const bf16x4 a0 = *(const LAS bf16x4*)(vp + 32 * kk), a1 = *(const LAS bf16x4*)(vp + 32 * kk + 16); O[dt] = mfma16(cat4(a0, a1), PB[kk], O[dt]); } }
            }
            if (kt + 1 < ntile) MOBA_STORE(cur ^ 1);
            __syncthreads();
        }
#undef MOBA_LOAD
#undef MOBA_STORE
        lrun += __shfl_xor(lrun, 16); lrun += __shfl_xor(lrun, 32);
        const float inv = 1.0f / lrun;
#pragma unroll
        for (int dt = 0; dt < 8; ++dt) *(u32x2*)(((bf16_t*)(p.ws + OFF_yB)) + (size_t)(qtok0 + myrow) * 1024 + h * 128 + 16 * dt + 4 * g4) = pack4(O[dt] * inv);
    }
    __syncthreads();
}

__device__ void gmlp_unit(const Params& p, LAS unsigned char* lds, int unit, int tid, int layer) {
    const int grp = unit & 3, cc = (unit >> 2) & 31, b = unit >> 7;
    const int tok0 = b * SEQ + cc * 128;
    LAS float* red = (LAS float*)lds; LAS float* sMean = red + 1024; LAS float* sRstd = sMean + 128;
    LAS bf16_t* vn = (LAS bf16_t*)(lds + 8192);
    { const int tok = tid & 127, part = tid >> 7; float s = 0.f, q = 0.f;
      const bf16_t* src = ((bf16_t*)(p.ws + OFF_ZT)) + (size_t)(TVC + part * 128) * MT + tok0 + tok;
#pragma unroll 8
      for (int ch = 0; ch < 128; ++ch) { const float x = bf2f(src[(size_t)ch * MT]); s += x; q += x * x; }
      red[(part * 128 + tok) * 2] = s; red[(part * 128 + tok) * 2 + 1] = q; }
    __syncthreads();
    if (tid < 128) { float s = 0.f, q = 0.f;
#pragma unroll
        for (int pt = 0; pt < 4; ++pt) { s += red[(pt * 128 + tid) * 2]; q += red[(pt * 128 + tid) * 2 + 1]; }
        const float mean = s * (1.0f / 512.0f); const float var = fmaxf(q * (1.0f / 512.0f) - mean * mean, 0.f);
        sMean[tid] = mean; sRstd[tid] = rsqrtf(var + 1e-6f); }
    __syncthreads();
    { const int e = tid >> 2, sc = (tid & 3) * 32; const int ch = grp * 128 + e;
      const float gg = p.in[6][layer * 512 + ch], bb = p.in[7][layer * 512 + ch];
      const bf16_t* src = ((bf16_t*)(p.ws + OFF_ZT)) + (size_t)(TVC + ch) * MT + tok0 + sc;
#pragma unroll
      for (int i = 0; i < 4; ++i) { const u32x4 v = *(const u32x4*)(src + 8 * i); const int s0 = sc + 8 * i;
          const f32x4 x0 = {bflo(v.x), bfhi(v.x), bflo(v.y), bfhi(v.y)}, x1 = {bflo(v.z), bfhi(v.z), bflo(v.w), bfhi(v.w)};
          f32x4 y0, y1;
#pragma unroll
          for (int j = 0; j < 4; ++j) { y0[j] = (x0[j] - sMean[s0 + j]) * sRstd[s0 + j] * gg + bb; y1[j] = (x1[j] - sMean[s0 + 4 + j]) * sRstd[s0 + 4 + j] * gg + bb; }
          *(LAS bf16x8*)(vn + e * 136 + s0) = pack8(y0, y1); } }
    __syncthreads();
    const int lane = tid & 63, w = tid >> 6, fr = lane & 15, g4 = lane >> 4;
    const int t = 16 * w + fr;
    f32x4 acc[8];
#pragma unroll
    for (int et = 0; et < 8; ++et) acc[et] = (f32x4){0.f, 0.f, 0.f, 0.f};
    const float* wrow = p.in[8] + (((size_t)layer * 4 + grp) * 128 + t) * 128;
    const int ksmax = (16 * w + 15) >> 5;
#pragma unroll
    for (int ks = 0; ks < 4; ++ks) if (ks <= ksmax) {
        const int s0 = 32 * ks + 8 * g4;
        f32x4 w0 = *(const f32x4*)(wrow + s0), w1 = *(const f32x4*)(wrow + s0 + 4);
#pragma unroll
        for (int j = 0; j < 4; ++j) { if (s0 + j > t) w0[j] = 0.f; if (s0 + 4 + j > t) w1[j] = 0.f; }
        const bf16x8 B = pack8(w0, w1);
#pragma unroll
        for (int et = 0; et < 8; ++et) acc[et] = mfma16(*(const LAS bf16x8*)(vn + (16 * et + fr) * 136 + s0), B, acc[et]);
    }
    const float bs = p.in[9][((size_t)layer * 4 + grp) * 128 + t];
#pragma unroll
    for (int et = 0; et < 8; ++et) {
        const int e0 = 16 * et + 4 * g4;
        const f32x4 uu = unpack4(*(const u32x2*)(((bf16_t*)(p.ws + OFF_Z)) + (size_t)(tok0 + t) * NZ + ZUC + grp * 128 + e0));
        f32x4 y;
#pragma unroll
        for (int j = 0; j < 4; ++j) y[j] = uu[j] * (acc[et][j] + bs);
        *(u32x2*)(((bf16_t*)(p.ws + OFF_yC)) + (size_t)(tok0 + t) * 512 + grp * 128 + e0) = pack4(y);
    }
    __syncthreads();
}

__device__ void final_norm(const Params& p, const float* ssq, int tid) {
    const int lane = tid & 63, w = tid >> 6;
    for (int row = blockIdx.x * 8 + w; row < MT; row += gridDim.x * 8) {
        float s = lane < 32 ? ssq[(size_t)row * 32 + lane] : 0.f;
        s = wave_sum(s);
        const float rs = rsqrtf(s * (1.0f / 2048.0f) + 1e-6f);
#pragma unroll
        for (int i = 0; i < 8; ++i) { const int k = 4 * lane + 256 * i; const f32x4 v = *(const f32x4*)(((float*)(p.ws + OFF_xres)) + (size_t)row * DM + k); const f32x4 g = *(const f32x4*)(p.in[20] + k); *(f32x4*)(p.out + (size_t)row * DM + k) = v * rs * g; }
    }
}

__global__ void __launch_bounds__(512, 2) mega(Params p) {
    extern __shared__ __attribute__((aligned(16))) unsigned char smem_[];
    LAS unsigned char* lds = (LAS unsigned char*)smem_;
    cg::grid_group grid = cg::this_grid();
    const int tid0 = threadIdx.x, G = gridDim.x, bid = blockIdx.x;
#define tid opq(tid0)
    int ph = 0;
#define PH_ON (ph >= p.ph_lo && ph < p.ph_hi)
#define PH_END do { if (PH_ON && ph + 1 < p.ph_hi) grid.sync(); ++ph; } while (0)
    if (PH_ON && PHM(0)) prologue(p, lds, tid);
    PH_END;
    for (int l = 0; l < 2; ++l) {
        const int cur = l & 1;
        bf16_t* xbc = cur ? ((bf16_t*)(p.ws + OFF_xb1)) : ((bf16_t*)(p.ws + OFF_xb0)); bf16_t* xbn = cur ? ((bf16_t*)(p.ws + OFF_xb0)) : ((bf16_t*)(p.ws + OFF_xb1));
        float* ssc = cur ? ((float*)(p.ws + OFF_ssq1)) : ((float*)(p.ws + OFF_ssq0)); float* ssn = cur ? ((float*)(p.ws + OFF_ssq0)) : ((float*)(p.ws + OFF_ssq1));
        const bf16_t* wti = ((bf16_t*)(p.ws + OFF_wt_in)) + (size_t)l * NWIN * 2048;
        if (PH_ON && PHM(1)) {
            gates_phase(p, l, l == 0 ? p.in[0] : ((float*)(p.ws + OFF_xres)), tid);
            { EpiZ E{((bf16_t*)(p.ws + OFF_Z)), ssc, ((float*)(p.ws + OFF_rope))}; run_gemm(lds, xbc, wti, MT, NZ, DM, E); }
            { EpiZT E{((bf16_t*)(p.ws + OFF_ZT)), ssc}; run_gemm(lds, wti + (size_t)NZ * 2048, xbc, NTR, MT, DM, E); }
        }
        PH_END;
        if (PH_ON && PHM(2)) {
            for (int u = bid; u < 512; u += G) mlstm_a_unit(p, lds, u, tid);
            for (int u = bid; u < 256; u += G) kmean_unit(p, lds, u, tid);
            for (int u = bid; u < 256; u += G) gmlp_unit(p, lds, u, tid, l);
        }
        PH_END;
        if (PH_ON && PHM(3)) {
            mlstm_scan(p, tid);
            for (int u = bid; u < 256; u += G) moba_unit(p, lds, u, tid);
        }
        PH_END;
        if (PH_ON && PHM(4)) { for (int u = bid; u < 512; u += G) mlstm_c_unit(p, lds, u, tid, l); }
        PH_END;
        if (PH_ON && PHM(5)) {
            { EpiBr<0> E{((bf16_t*)(p.ws + OFF_Z)), ((float*)(p.ws + OFF_merged)), ((bf16_t*)(p.ws + OFF_mergedb))}; run_gemm(lds, ((bf16_t*)(p.ws + OFF_yA)), ((bf16_t*)(p.ws + OFF_wt_a)) + (size_t)l * 2048 * 512, MT, DM, 512, E); }
            { EpiBr<1> E{((bf16_t*)(p.ws + OFF_Z)), ((float*)(p.ws + OFF_merged)), ((bf16_t*)(p.ws + OFF_mergedb))}; run_gemm(lds, ((bf16_t*)(p.ws + OFF_yB)), ((bf16_t*)(p.ws + OFF_wt_b)) + (size_t)l * 2048 * 1024, MT, DM, 1024, E); }
            { EpiBr<2> E{((bf16_t*)(p.ws + OFF_Z)), ((float*)(p.ws + OFF_merged)), ((bf16_t*)(p.ws + OFF_mergedb))}; run_gemm(lds, ((bf16_t*)(p.ws + OFF_yC)), ((bf16_t*)(p.ws + OFF_wt_c)) + (size_t)l * 2048 * 512, MT, DM, 512, E); }
        }
        PH_END;
        if (PH_ON && PHM(6)) { EpiRes<0> E{l == 0 ? p.in[0] : ((float*)(p.ws + OFF_xres)), ((float*)(p.ws + OFF_xres)), xbn, ssn, nullptr, nullptr}; run_gemm(lds, ((bf16_t*)(p.ws + OFF_mergedb)), ((bf16_t*)(p.ws + OFF_wt_out)) + (size_t)l * 2048 * 2048, MT, DM, DM, E); }
        PH_END;
        if (PH_ON && PHM(7)) {
            { EpiUp E{((bf16_t*)(p.ws + OFF_hidden)), ssn}; run_gemm(lds, xbn, ((bf16_t*)(p.ws + OFF_wt_up)) + (size_t)l * 8192 * 2048, MT, FF, DM, E); }
            { EpiP E{((bf16_t*)(p.ws + OFF_pple)), DM}; run_gemm(lds, ((bf16_t*)(p.ws + OFF_pb)) + (size_t)l * MT * 256, ((bf16_t*)(p.ws + OFF_wt_pe)) + (size_t)l * 2048 * 256, MT, DM, 256, E); }
        }
        PH_END;
        if (PH_ON && PHM(8)) { EpiRes<0> E{((float*)(p.ws + OFF_xres)), ((float*)(p.ws + OFF_xres)), xbc, ssc, nullptr, nullptr}; run_gemm(lds, ((bf16_t*)(p.ws + OFF_hidden)), ((bf16_t*)(p.ws + OFF_wt_down)) + (size_t)l * 2048 * 8192, MT, DM, FF, E); }
        PH_END;
        if (PH_ON && PHM(9)) { EpiRes<1> E{((float*)(p.ws + OFF_xres)), ((float*)(p.ws + OFF_xres)), xbn, ssn, ssc, ((bf16_t*)(p.ws + OFF_pple))}; run_gemm(lds, xbc, ((bf16_t*)(p.ws + OFF_wt_pg)) + (size_t)l * 2048 * 2048, MT, DM, DM, E); }
        PH_END;
    }
    if (PH_ON && PHM(10)) final_norm(p, ((float*)(p.ws + OFF_ssq0)), tid);
#undef PH_ON
#undef PH_END
#undef tid
}

__global__ void fill_diag(float* o, int n, float v) { for (int i = blockIdx.x * blockDim.x + threadIdx.x; i < n; i += gridDim.x * blockDim.x) o[i] = v; }
extern "C" void kernel_launch(void* const* d_in, const int* in_sizes, int n_in, void* d_out, int out_size, void* d_ws, size_t ws_size, hipStream_t stream) {
    static int grid_blocks = 0;
    if (!grid_blocks) {
        int dev = 0, cus = 0, per_cu = 0;
        hipGetDevice(&dev);
        hipDeviceGetAttribute(&cus, hipDeviceAttributeMultiprocessorCount, dev);
        hipFuncSetAttribute((const void*)mega, hipFuncAttributeMaxDynamicSharedMemorySize, LDS_BYTES);
        hipOccupancyMaxActiveBlocksPerMultiprocessor(&per_cu, (const void*)mega, 512, LDS_BYTES);
        if (per_cu < 1) { fprintf(stderr, "kernel_launch: occupancy query says %d blocks per CU\n", per_cu); per_cu = 1; }
        grid_blocks = cus * 1;
        (void)hipGetLastError();
    }
    Params p{};
    for (int i = 0; i < 21; ++i) p.in[i] = (const float*)d_in[i];
    p.out = (float*)d_out; p.ws = (unsigned char*)d_ws;
    if (n_in != 21 || OFF_END > ws_size) { fill_diag<<<1024, 256, 0, stream>>>((float*)d_out, out_size, n_in != 21 ? 50000.f + n_in : (float)(ws_size >> 20)); return; }
#if N_LAUNCH_MODE == 0
    p.ph_lo = 0; p.ph_hi = PHASE_LIMIT;
    void* args[] = {&p};
    hipError_t e = hipLaunchCooperativeKernel((const void*)mega, dim3(grid_blocks), dim3(512), args, LDS_BYTES, stream);
    if (e != hipSuccess) fprintf(stderr, "kernel_launch: cooperative launch failed: %s (grid %d)\n", hipGetErrorString(e), grid_blocks);
#else
    for (int ph = 0; ph < PHASE_LIMIT; ++ph) { p.ph_lo = ph; p.ph_hi = ph + 1; hipLaunchKernelGGL(mega, dim3(grid_blocks), dim3(512), LDS_BYTES, stream, p); }
#endif
}
```

```cpp
#include <hip/hip_runtime.h>
#include <hip/hip_cooperative_groups.h>
#include <cstdio>
namespace cg = cooperative_groups;
namespace pg8 {
#define PG8_LAS __attribute__((address_space(3)))
typedef unsigned short bf16_t;
typedef short bf16x8 __attribute__((ext_vector_type(8)));
typedef float f32x4 __attribute__((ext_vector_type(4)));
typedef unsigned u32x4 __attribute__((ext_vector_type(4)));
constexpr int BM = 256, BK = 64, HALF = 128, HTB = HALF * BK * 2  , STAGE_BYTES = 8 * HTB, NXCD = 8, WGM = 8;

__host__ __device__ __forceinline__ int lds_byte(int r, int c) { const int st = (r >> 4) * 2 + (c >> 5), rr = r & 15, cc = c & 31, ob = rr * 64 + cc * 2; return st * 1024 + (ob ^ (((ob >> 9) & 1) << 5)); }
__host__ __device__ __forceinline__ void stage_rc(int b, int& R, int& C) { const int st = b / 1024, sb = b % 1024, swz = sb ^ (((sb >> 9) & 1) << 5); R = (st >> 1) * 16 + swz / 64; C = (st & 1) * 32 + (swz % 64) / 2; }
__host__ __device__ __forceinline__ int perm32(int rho) { const int n = rho >> 4, i = rho & 15; return 8 * (i >> 2) + 4 * n + (i & 3); }

struct Unit { int pm, pn, kt0, nkt, zero; };
struct Gemm { const bf16_t* A; const bf16_t* Bt; int M, N, K; };

struct StaticOrder {
    int nM, nN, nwg, G, c, nkt;
    __host__ __device__ void init(int M, int N, int G_, int c_, int K_) { nM = M / BM; nN = N / BM; nwg = nM * nN; G = G_; c = c_; nkt = K_ / BK; }
    __host__ __device__ bool next(int i, Unit& u) const {
        const long L = (long)i * G + c; if (L >= nwg) return false;
        int wgid = (int)L; { const int q = nwg / NXCD, r = nwg % NXCD, xcd = wgid % NXCD, off = wgid / NXCD; wgid = (xcd < r ? xcd * (q + 1) : r * (q + 1) + (xcd - r) * q) + off; }
        const int nig = WGM * nN, gid = wgid / nig, fm = gid * WGM, gsz = (nM - fm) < WGM ? (nM - fm) : WGM;
        u.pm = fm + ((wgid % nig) % gsz); u.pn = (wgid % nig) / gsz; u.kt0 = 0; u.nkt = nkt; u.zero = 1; return true;
    }
    __device__ __forceinline__ void a_ready(const Unit&) const {}
    __device__ __forceinline__ void done(const Unit&) const {}
};
__device__ __forceinline__ unsigned cvt_pk_bf16(float lo, float hi) { unsigned r; asm volatile("v_cvt_pk_bf16_f32 %0, %1, %2" : "=v"(r) : "v"(lo), "v"(hi)); return r; }
typedef float f32x2 __attribute__((ext_vector_type(2)));
template <class Epi, class Sched, bool STAMP = false>
__device__ __forceinline__ void gemm_phase(PG8_LAS unsigned char* lds, const Gemm g, const Sched& S, const Epi& E, unsigned long long* stamps) {
    int tid_ = threadIdx.x; asm volatile("" : "+v"(tid_)); const int tid = tid_, wid = __builtin_amdgcn_readfirstlane(tid >> 6), lane = tid & 63, wr = wid >> 2, wc = wid & 3, fr = lane & 15, fq = lane >> 4;
    const int K = g.K;
    int ts_lo = 0, ts_hi = 0, nts = 0; const unsigned long long rt_entry = STAMP ? (unsigned long long)wall_clock64() : 0ull;
#define PG8_STAMP() do { if (STAMP && wid == 0 && nts < 64) { const unsigned long long _c = (unsigned long long)clock64(); \
        ts_lo = (lane == nts) ? (int)(unsigned)_c : ts_lo; ts_hi = (lane == nts) ? (int)(unsigned)(_c >> 32) : ts_hi; ++nts; } } while (0)
    PG8_STAMP();
    unsigned voffA[2], voffB[2];
#pragma unroll
    for (int i = 0; i < 2; ++i) { int R, C; stage_rc(tid * 16 + i * 8192, R, C); const int Rb = Epi::PERM ? ((R & ~31) + perm32(R & 31)) : R;
        voffA[i] = (unsigned)(R * K + C) * 2u; voffB[i] = (unsigned)(Rb * K + C) * 2u; }
    const size_t kstep = (size_t)(BK * 2);
    const size_t hstep = (size_t)HALF * K * 2;
    const size_t tstep = 2 * hstep;
    const unsigned ldsw = (unsigned)wid * 1024u;
    const int aoff = lds_byte(wr * 64 + fr, fq * 8), boff = lds_byte(wc * 32 + fr, fq * 8);
#define PG8_SA(b, h) (((b) * 2 + (h)) * HTB)
#define PG8_SB(b, h) ((4 + (b) * 2 + (h)) * HTB)
#define PG8_STAGE(bufoff, gbase, voff) do { _Pragma("unroll") for (int _i = 0; _i < 2; ++_i) \
        __builtin_amdgcn_global_load_lds((const unsigned*)((const char*)(gbase) + (voff)[_i]), (PG8_LAS unsigned*)(lds + (bufoff) + ldsw + _i * 8192), 16, 0, 0); } while (0)
#define PG8_LDA(dst, b, h) do { _Pragma("unroll") for (int m = 0; m < 4; ++m) _Pragma("unroll") for (int k = 0; k < 2; ++k) dst[m][k] = *(const PG8_LAS bf16x8*)(lds + PG8_SA(b, h) + aoff + m * 2048 + k * 1024); } while (0)
#define PG8_LDB(dst, b, h) do { _Pragma("unroll") for (int n = 0; n < 2; ++n) _Pragma("unroll") for (int k = 0; k < 2; ++k) dst[n][k] = *(const PG8_LAS bf16x8*)(lds + PG8_SB(b, h) + boff + n * 2048 + k * 1024); } while (0)
#define PG8_MMA(ai, bj, At, Bt) do { __builtin_amdgcn_s_setprio(1); _Pragma("unroll") for (int m = 0; m < 4; ++m) _Pragma("unroll") for (int n = 0; n < 2; ++n) _Pragma("unroll") for (int k = 0; k < 2; ++k) \
        acc[ai][bj][m][n] = __builtin_amdgcn_mfma_f32_16x16x32_bf16(Bt[n][k], At[m][k], acc[ai][bj][m][n], 0, 0, 0); __builtin_amdgcn_s_setprio(0); } while (0)
#define PG8_WAIT_V(n) asm volatile("s_waitcnt vmcnt(" #n ")" ::: "memory")
#define PG8_WAIT_L(n) asm volatile("s_waitcnt lgkmcnt(" #n ")" ::: "memory")
#define PG8_BAR __builtin_amdgcn_s_barrier()
#define PG8_SCHED __builtin_amdgcn_sched_barrier(0)
    Unit cur, nxt; int ui = 0;
    if (!S.next(0, cur)) return;
    f32x4 acc[2][2][4][2];
#pragma unroll
    for (int a = 0; a < 2; ++a)
#pragma unroll
        for (int b = 0; b < 2; ++b)
#pragma unroll
            for (int m = 0; m < 4; ++m)
#pragma unroll
                for (int n = 0; n < 2; ++n) acc[a][b][m][n] = (f32x4){0.f, 0.f, 0.f, 0.f};
    bf16x8 At[4][2], B0[2][2], B1[2][2];
    const char* cA = (const char*)g.A + (size_t)cur.pm * tstep + (size_t)cur.kt0 * kstep; const char* cB = (const char*)g.Bt + (size_t)cur.pn * tstep + (size_t)cur.kt0 * kstep;
    S.a_ready(cur);
    PG8_STAGE(PG8_SB(0, 0), cB, voffB); PG8_STAGE(PG8_SB(0, 1), cB + hstep, voffB); PG8_STAGE(PG8_SA(0, 0), cA, voffA); PG8_STAGE(PG8_SA(0, 1), cA + hstep, voffA);
    if (wr == 1) PG8_BAR;
    PG8_WAIT_V(2); PG8_BAR;
    PG8_STAGE(PG8_SB(1, 0), cB + kstep, voffB); PG8_STAGE(PG8_SA(1, 0), cA + kstep, voffA); PG8_STAGE(PG8_SB(1, 1), cB + hstep + kstep, voffB);
    PG8_WAIT_V(6); PG8_BAR;
    PG8_STAMP();
    for (;;) {
        const bool has_next = S.next(ui + 1, nxt);
        const char* nA = has_next ? (const char*)g.A + (size_t)nxt.pm * tstep + (size_t)nxt.kt0 * kstep : cA; const char* nB = has_next ? (const char*)g.Bt + (size_t)nxt.pn * tstep + (size_t)nxt.kt0 * kstep : cB;
        const int nt = cur.nkt;
        for (int t = 0; t < nt; t += 2) {
            const bool last = (t == nt - 2);
            const char* a1 = cA + (size_t)(t + 1) * kstep;
            const char* a2 = last ? nA : cA + (size_t)(t + 2) * kstep; const char* b2 = last ? nB : cB + (size_t)(t + 2) * kstep;
            const char* a3 = a2 + kstep; const char* b3 = b2 + kstep;
            if (last && has_next) S.a_ready(nxt);
            PG8_LDB(B0, 0, 0); PG8_LDB(B1, 0, 1); PG8_SCHED; PG8_LDA(At, 0, 0); PG8_STAGE(PG8_SA(1, 1), a1 + hstep, voffA);
            PG8_WAIT_V(8); PG8_WAIT_L(0); PG8_BAR; PG8_MMA(0, 0, At, B0); PG8_MMA(0, 1, At, B1); PG8_BAR; PG8_SCHED;
            PG8_LDA(At, 0, 1); PG8_STAGE(PG8_SB(0, 0), b2, voffB); PG8_STAGE(PG8_SB(0, 1), b2 + hstep, voffB); PG8_STAGE(PG8_SA(0, 0), a2, voffA);
            PG8_WAIT_V(8); PG8_WAIT_L(0); PG8_BAR; PG8_MMA(1, 0, At, B0); PG8_MMA(1, 1, At, B1); PG8_BAR; PG8_SCHED;
            PG8_LDB(B0, 1, 0); PG8_LDB(B1, 1, 1); PG8_SCHED; PG8_LDA(At, 1, 0); PG8_STAGE(PG8_SA(0, 1), a2 + hstep, voffA);
            PG8_WAIT_V(8); PG8_WAIT_L(0); PG8_BAR; PG8_MMA(0, 0, At, B0); PG8_MMA(0, 1, At, B1); PG8_BAR; PG8_SCHED;
            PG8_LDA(At, 1, 1); PG8_STAGE(PG8_SB(1, 0), b3, voffB); PG8_STAGE(PG8_SB(1, 1), b3 + hstep, voffB); PG8_STAGE(PG8_SA(1, 0), a3, voffA);
            PG8_WAIT_V(8); PG8_WAIT_L(0); PG8_BAR; PG8_MMA(1, 0, At, B0); PG8_MMA(1, 1, At, B1); PG8_BAR; PG8_SCHED;
        }
        PG8_STAMP();
        if (wr == 0) PG8_BAR;
        if constexpr (Epi::HAS_MID) { E.mid(acc, cur, wr, wc, fr, fq); } else if constexpr (!Epi::AFTER_DRAIN) { E(acc, cur, wr, wc, fr, fq); S.done(cur); }
        PG8_STAMP();
        if (!has_next) break;
        if (cur.zero)
#pragma unroll
        for (int a = 0; a < 2; ++a)
#pragma unroll
            for (int b = 0; b < 2; ++b)
#pragma unroll
                for (int m = 0; m < 4; ++m)
#pragma unroll
                    for (int n = 0; n < 2; ++n) acc[a][b][m][n] = (f32x4){0.f, 0.f, 0.f, 0.f};
        cur = nxt; cA = nA; cB = nB; ++ui;
        if (wr == 1) PG8_BAR;
    }
    PG8_WAIT_V(0);
    PG8_BAR;
    if constexpr (Epi::AFTER_DRAIN) { E.fused(acc, cur, wr, wc, fr, fq, lds, wid, lane); S.done(cur); }
    PG8_STAMP();
    if (STAMP && wid == 0) { stamps[lane] = lane < nts ? (((unsigned long long)(unsigned)ts_hi << 32) | (unsigned)ts_lo) : 0ull;
        if (lane == 62) stamps[62] = rt_entry; if (lane == 63) stamps[63] = (unsigned long long)wall_clock64(); }
#undef PG8_STAMP
#undef PG8_SA
#undef PG8_SB
#undef PG8_STAGE
#undef PG8_LDA
#undef PG8_LDB
#undef PG8_MMA
#undef PG8_WAIT_V
#undef PG8_WAIT_L
#undef PG8_BAR
#undef PG8_SCHED
}
}

using pg8::bf16_t; using pg8::bf16x8; using pg8::f32x4; using pg8::u32x4; using pg8::cvt_pk_bf16; using pg8::Unit;
#define LAS __attribute__((address_space(3)))
typedef unsigned u32x2 __attribute__((ext_vector_type(2)));
#define XB_TMO      128
#define XB_XCNT(j)  (256  + 64 * (j))
#define XB_XSUB(j)  (1280 + 64 * (j))
#define XB_XGEN(j)  (2304 + 64 * (j))
#define XB_TOP      3328
#define XB_TOPGEN   3392
#define XCD_BAR_WORDS 3456
#define XB_SPIN_CAP (1u << 18)

__device__ __forceinline__ unsigned xb_ld(unsigned* p)              { return __hip_atomic_load(p, __ATOMIC_RELAXED, __HIP_MEMORY_SCOPE_AGENT); }
__device__ __forceinline__ unsigned xb_add(unsigned* p, unsigned v) { return __hip_atomic_fetch_add(p, v, __ATOMIC_RELAXED, __HIP_MEMORY_SCOPE_AGENT); }
__device__ __forceinline__ unsigned xb_xcc_id() { return (unsigned)__builtin_amdgcn_s_getreg((3 << 11) | 20) & 0xFu; }
#define XB_SPIN(cond, bar) do { unsigned _sp = 0; while (cond) { __builtin_amdgcn_s_sleep(1); \
    if ((++_sp & 255u) == 0u) { if (xb_ld(&(bar)[XB_TMO])) break; if (_sp > XB_SPIN_CAP) { atomicAdd(&(bar)[XB_TMO], 1u); break; } } } } while (0)

struct XcdBarrier {
    unsigned* bar; unsigned x;
    volatile LAS unsigned* st;
};

__device__ __forceinline__ XcdBarrier xcd_barrier_post(unsigned* bar, volatile LAS unsigned* st) {
    XcdBarrier b; b.bar = bar; b.x = xb_xcc_id(); b.st = st;
    if (threadIdx.x == 0) (void)xb_add(&bar[XB_XCNT(b.x)], 1u);
    return b;
}
__device__ __forceinline__ void xcd_barrier_complete(unsigned* bar, unsigned x, unsigned& nloc, unsigned& nx) {
    const unsigned G = gridDim.x * gridDim.y * gridDim.z;
    unsigned sum, cnt, mine, sp = 0u;
    for (;;) {
        sum = 0u; cnt = 0u; mine = 0u;
#pragma unroll
        for (unsigned j = 0; j < 16; ++j) { const unsigned c = xb_ld(&bar[XB_XCNT(j)]); sum += c; cnt += (c > 0u) ? 1u : 0u; mine = (j == x) ? c : mine; }
        if (sum == G) break;
        __builtin_amdgcn_s_sleep(1);
        if ((++sp & 255u) == 0u) { if (xb_ld(&bar[XB_TMO])) break; if (sp > XB_SPIN_CAP) { atomicAdd(&bar[XB_TMO], 1u); break; } }
    }
    nloc = mine > 0u ? mine : 1u; nx = cnt > 0u ? cnt : 1u;
}

__device__ __forceinline__ void xcd_barrier(const XcdBarrier& b) {
    asm volatile("s_waitcnt vmcnt(0)" ::: "memory");
    __syncthreads();
    if (threadIdx.x == 0) {
        unsigned* bar = b.bar;
        __builtin_amdgcn_s_waitcnt(0);
        unsigned nloc = b.st[0], nx = b.st[1];
        if (nloc == 0u) { xcd_barrier_complete(bar, b.x, nloc, nx); b.st[0] = nloc; b.st[1] = nx; }
        const unsigned old = xb_add(&bar[XB_XSUB(b.x)], 1u);
        const unsigned gen = old / nloc;
        if (old + 1u == (gen + 1u) * nloc) {
            __builtin_amdgcn_fence(__ATOMIC_RELEASE, "agent");
            asm volatile("s_waitcnt vmcnt(0)" ::: "memory");
            const unsigned og = xb_add(&bar[XB_TOP], 1u);
            const unsigned tg = og / nx;
            if (og + 1u == (tg + 1u) * nx) xb_add(&bar[XB_TOPGEN], 1u);
            else XB_SPIN(xb_ld(&bar[XB_TOPGEN]) == tg, bar);
            __builtin_amdgcn_fence(__ATOMIC_ACQUIRE, "agent");
            xb_add(&bar[XB_XGEN(b.x)], 1u);
            asm volatile("s_waitcnt vmcnt(0)" ::: "memory");
        } else {
            XB_SPIN(xb_ld(&bar[XB_XGEN(b.x)]) == gen, bar);
            __builtin_amdgcn_fence(__ATOMIC_ACQUIRE, "agent");
            asm volatile("s_waitcnt vmcnt(0)" ::: "memory");
        }
    }
    __syncthreads();
}

typedef short bf16x4 __attribute__((ext_vector_type(4)));

#ifndef PHASE_LIMIT
#define PHASE_LIMIT N_PHASES
#endif
#ifndef REP_MASK
#define REP_MASK 0
#endif
#define REPM(k) (((REP_MASK) >> (k)) & 1)
#ifndef PHASE_MASK
#define PHASE_MASK 0xfff
#endif
#define PHM(k) (((PHASE_MASK) >> (k)) & 1)
#ifndef N_LAUNCH_MODE
#define N_LAUNCH_MODE 0
#endif

constexpr int MT = 8192, DM = 2048, SEQ = 4096, NZ = 10240, NTR = 2048, FF = 8192, NWIN = 12288, WIN_LD = 12296;
constexpr int ZQA = 0, ZKA = 512, ZOA = 1024, ZQB = 1536, ZKB = 2560, ZUC = 3584, ZG = 4096;
constexpr int TVA = 0, TVB = 512, TVC = 1536;
constexpr int XST_OFF = 139264;
constexpr int LDS_BYTES = XST_OFF + 256;
constexpr int N_PHASES = 1 + 10 * 2 + 1;

constexpr size_t al256(size_t x) { return (x + 255) & ~(size_t)255; }
constexpr size_t OFF_wt_in = 0;
constexpr size_t OFF_wt_a = OFF_wt_in + al256((size_t)2 * NWIN * 2048 * 2);
constexpr size_t OFF_wt_b = OFF_wt_a + al256((size_t)2 * 2048 * 512 * 2);
constexpr size_t OFF_wt_c = OFF_wt_b + al256((size_t)2 * 2048 * 1024 * 2);
constexpr size_t OFF_wt_out = OFF_wt_c + al256((size_t)2 * 2048 * 512 * 2);
constexpr size_t OFF_wt_up = OFF_wt_out + al256((size_t)2 * 2048 * 2048 * 2);
constexpr size_t OFF_wt_down = OFF_wt_up + al256((size_t)2 * 8192 * 2048 * 2);
constexpr size_t OFF_wt_pg = OFF_wt_down + al256((size_t)2 * 2048 * 8192 * 2);
constexpr size_t OFF_wt_pe = OFF_wt_pg + al256((size_t)2 * 2048 * 2048 * 2);
constexpr size_t OFF_gw = OFF_wt_pe + al256((size_t)2 * 2048 * 256 * 2);
constexpr size_t OFF_rope = OFF_gw + al256((size_t)2 * 2048 * 8 * 4);
constexpr size_t OFF_pb = OFF_rope + al256((size_t)SEQ * 16 * 2 * 4);
constexpr size_t OFF_xres = OFF_pb + al256((size_t)2 * MT * 256 * 2);
constexpr size_t OFF_xb0 = OFF_xres + al256((size_t)MT * DM * 4);
constexpr size_t OFF_xb1 = OFF_xb0 + al256((size_t)MT * DM * 2);
constexpr size_t OFF_ssq0 = OFF_xb1 + al256((size_t)MT * DM * 2);
constexpr size_t OFF_ssq1 = OFF_ssq0 + al256((size_t)MT * 32 * 4);
constexpr size_t OFF_Z = OFF_ssq1 + al256((size_t)MT * 32 * 4);
constexpr size_t OFF_ZT = OFF_Z + al256((size_t)MT * NZ * 2);
constexpr size_t OFF_GT = OFF_ZT + al256((size_t)NTR * MT * 2);
constexpr size_t OFF_dC = OFF_GT + al256((size_t)MT * 8 * 4);
constexpr size_t OFF_dn = OFF_dC + al256((size_t)8 * 64 * 16384 * 4);
constexpr size_t OFF_gsc = OFF_dn + al256((size_t)8 * 64 * 128 * 4);
constexpr size_t OFF_Cprev = OFF_gsc + al256((size_t)8 * 64 * 2 * 4);
constexpr size_t OFF_nprev = OFF_Cprev + al256((size_t)8 * 64 * 16384 * 2);
constexpr size_t OFF_mprev = OFF_nprev + al256((size_t)8 * 64 * 128 * 4);
constexpr size_t OFF_kmean = OFF_mprev + al256((size_t)8 * 64 * 4);
constexpr size_t OFF_yA = OFF_kmean + al256((size_t)16 * 16 * 128 * 4);
constexpr size_t OFF_yB = OFF_yA + al256((size_t)MT * 512 * 2);
constexpr size_t OFF_yC = OFF_yB + al256((size_t)MT * 1024 * 2);
constexpr size_t OFF_merged = OFF_xb0;
constexpr size_t OFF_mergedb = OFF_ZT;
constexpr size_t OFF_hidden = OFF_Z;
constexpr size_t OFF_pple = OFF_ZT;
constexpr size_t OFF_bar = OFF_yC + al256((size_t)MT * 512 * 2);
constexpr size_t OFF_selm = OFF_bar + al256((size_t)XCD_BAR_WORDS * 4);
constexpr size_t OFF_cnt = OFF_selm + al256((size_t)16 * 4096 * 4);
constexpr size_t OFF_list = OFF_cnt + al256((size_t)256 * 4);
constexpr size_t OFF_ml = OFF_list + al256((size_t)256 * 4096 * 2);
constexpr size_t OFF_opart = OFF_xb0;
constexpr size_t OFF_END = OFF_ml + al256((size_t)16 * 4096 * 4 * 2 * 4);
struct Params { const float* in[21]; float* out; unsigned char* ws; int ph_lo, ph_hi; };

__device__ __forceinline__ int opq(int v) { asm volatile("" : "+v"(v)); return v; }
__device__ __forceinline__ float bf2f(bf16_t b) { return __uint_as_float(((unsigned)b) << 16); }
__device__ __forceinline__ float bflo(unsigned w) { return __uint_as_float(w << 16); }
__device__ __forceinline__ float bfhi(unsigned w) { return __uint_as_float(w & 0xffff0000u); }
__device__ __forceinline__ bf16_t f2bf(float f) { return (bf16_t)(cvt_pk_bf16(f, 0.f) & 0xffffu); }
__device__ __forceinline__ float ex2(float x) { return __builtin_amdgcn_exp2f(x); }
__device__ __forceinline__ float sigm(float x) { return __builtin_amdgcn_rcpf(1.f + ex2(-1.4426950408889634f * x)); }
__device__ __forceinline__ float gelu_t(float x) { const float u = 0.7978845608028654f * (x + 0.044715f * x * x * x); return x * sigm(2.f * u); }
__device__ __forceinline__ float wave_sum(float v) {
#pragma unroll
    for (int o = 32; o >= 1; o >>= 1) v += __shfl_xor(v, o);
    return v; }
__device__ __forceinline__ float wave_max(float v) {
#pragma unroll
    for (int o = 32; o >= 1; o >>= 1) v = fmaxf(v, __shfl_xor(v, o));
    return v; }
__device__ __forceinline__ float wave_scan_add(float v, int lane) {
#pragma unroll
    for (int o = 1; o < 64; o <<= 1) { const float t = __shfl_up(v, o); if (lane >= o) v += t; }
    return v; }
__device__ __forceinline__ float wave_scan_max(float v, int lane) {
#pragma unroll
    for (int o = 1; o < 64; o <<= 1) { const float t = __shfl_up(v, o); if (lane >= o) v = fmaxf(v, t); }
    return v; }
__device__ __forceinline__ f32x4 mfma16(bf16x8 a, bf16x8 b, f32x4 c) { return __builtin_amdgcn_mfma_f32_16x16x32_bf16(a, b, c, 0, 0, 0); }
__device__ __forceinline__ bf16x8 pack8(f32x4 a, f32x4 b) {
    u32x4 w; w.x = cvt_pk_bf16(a[0], a[1]); w.y = cvt_pk_bf16(a[2], a[3]); w.z = cvt_pk_bf16(b[0], b[1]); w.w = cvt_pk_bf16(b[2], b[3]);
    return __builtin_bit_cast(bf16x8, w); }
__device__ __forceinline__ bf16x8 cat4(bf16x4 a, bf16x4 b) { return __builtin_shufflevector(a, b, 0, 1, 2, 3, 4, 5, 6, 7); }
__device__ __forceinline__ u32x2 pack4(f32x4 a) { u32x2 w; w.x = cvt_pk_bf16(a[0], a[1]); w.y = cvt_pk_bf16(a[2], a[3]); return w; }
__device__ __forceinline__ f32x4 unpack4(u32x2 w) { return (f32x4){bflo(w.x), bfhi(w.x), bflo(w.y), bfhi(w.y)}; }
__device__ __forceinline__ float log_sigmoid(float x) { return fminf(x, 0.f) - log1pf(expf(-fabsf(x))); }

__device__ __forceinline__ float row_rstd(const float* ssq, int row, int fq) {
    const f32x4* q = (const f32x4*)(ssq + (size_t)row * 32 + fq * 8);
    const f32x4 a = q[0], b = q[1];
    float s = ((a[0] + a[1]) + (a[2] + a[3])) + ((b[0] + b[1]) + (b[2] + b[3]));
    s += __shfl_xor(s, 16); s += __shfl_xor(s, 32);
    return rsqrtf(s * (1.0f / 2048.0f) + 1e-6f);
}

struct EpiZ {
    static constexpr bool PERM = true, AFTER_DRAIN = false, HAS_MID = false;
    bf16_t* Z; const float* ssq; const float* rope;
    __device__ __forceinline__ void operator()(const f32x4 (&acc)[2][2][4][2], const Unit& u, int wr, int wc, int fr, int fq) const {
        const int pn = u.pn;
        int mode = 0; float scl = 1.f;
        if (pn < 2) mode = 0; else if (pn < 4) scl = 0.08838834764831845f; else if (pn < 6) mode = 1; else if (pn < 14) { mode = 2; if (pn < 10) scl = 0.08838834764831845f * 1.4426950408889634f; } else if (pn < 16) mode = 3; else mode = 1;
        const bool rot = (mode == 2) && (wc == 0);
        const float sg = (fq < 2) ? -1.f : 1.f;
        const int row0 = u.pm * 256 + wr * 64 + fr, col0 = pn * 256 + wc * 32 + 8 * fq;
        float rsv[2][4];
#pragma unroll
        for (int ai = 0; ai < 2; ++ai)
#pragma unroll
            for (int m = 0; m < 4; ++m) rsv[ai][m] = row_rstd(ssq, row0 + ai * 128 + m * 16, fq) * scl;
#pragma unroll
        for (int ai = 0; ai < 2; ++ai)
#pragma unroll
            for (int m = 0; m < 4; ++m) {
                const int row = row0 + ai * 128 + m * 16;
                const float rs = rsv[ai][m];
                bf16_t* rowp = Z + (size_t)row * NZ + col0;
                f32x4 cs0 = {0.f, 0.f, 0.f, 0.f}, cs1 = cs0, cs2 = cs0, cs3 = cs0;
                if (rot) { const f32x4* rp = (const f32x4*)(rope + ((size_t)(row & (SEQ - 1)) * 16 + 8 * (fq & 1)) * 2); cs0 = rp[0]; cs1 = rp[1]; cs2 = rp[2]; cs3 = rp[3]; }
#pragma unroll
                for (int bj = 0; bj < 2; ++bj) {
                    f32x4 v0 = acc[ai][bj][m][0] * rs, v1 = acc[ai][bj][m][1] * rs;
                    if (mode == 1) {
#pragma unroll
                        for (int j = 0; j < 4; ++j) { v0[j] = sigm(v0[j]); v1[j] = sigm(v1[j]); } }
                    if (mode == 3) {
#pragma unroll
                        for (int j = 0; j < 4; ++j) { v0[j] = gelu_t(v0[j]); v1[j] = gelu_t(v1[j]); } }
                    if (rot) {
                        f32x4 p0, p1;
#pragma unroll
                        for (int j = 0; j < 4; ++j) { p0[j] = __shfl_xor(v0[j], 32); p1[j] = __shfl_xor(v1[j], 32); }
                        f32x4 o0, o1;
                        o0[0] = v0[0] * cs0[0] + sg * p0[0] * cs0[1]; o0[1] = v0[1] * cs0[2] + sg * p0[1] * cs0[3];
                        o0[2] = v0[2] * cs1[0] + sg * p0[2] * cs1[1]; o0[3] = v0[3] * cs1[2] + sg * p0[3] * cs1[3];
                        o1[0] = v1[0] * cs2[0] + sg * p1[0] * cs2[1]; o1[1] = v1[1] * cs2[2] + sg * p1[1] * cs2[3];
                        o1[2] = v1[2] * cs3[0] + sg * p1[2] * cs3[1]; o1[3] = v1[3] * cs3[2] + sg * p1[3] * cs3[3];
                        v0 = o0; v1 = o1;
                    }
                    *(bf16x8*)(rowp + bj * 128) = pack8(v0, v1);
                }
            }
    }
};
struct EpiZT {
    static constexpr bool PERM = true, AFTER_DRAIN = false, HAS_MID = false;
    bf16_t* ZT; const float* ssq;
    __device__ __forceinline__ void operator()(const f32x4 (&acc)[2][2][4][2], const Unit& u, int wr, int wc, int fr, int fq) const {
        const bool gel = u.pm >= 6;
        const int lane = fq * 16 + fr;
        const int tokL = u.pn * 256 + 128 * (lane >> 5) + 32 * wc + (lane & 31);
        const f32x4* q = (const f32x4*)(ssq + (size_t)tokL * 32);
        float s = 0.f;
#pragma unroll
        for (int i = 0; i < 8; ++i) { const f32x4 a = q[i]; s += (a[0] + a[1]) + (a[2] + a[3]); }
        const float rsL = rsqrtf(s * (1.0f / 2048.0f) + 1e-6f);
        f32x4 rsv[2][2];
#pragma unroll
        for (int bj = 0; bj < 2; ++bj)
#pragma unroll
            for (int n = 0; n < 2; ++n)
#pragma unroll
                for (int i = 0; i < 4; ++i) rsv[bj][n][i] = __shfl(rsL, bj * 32 + 8 * fq + 4 * n + i);
        const int row0 = u.pm * 256 + wr * 64 + fr, col0 = u.pn * 256 + wc * 32 + 8 * fq;
#pragma unroll
        for (int ai = 0; ai < 2; ++ai)
#pragma unroll
            for (int m = 0; m < 4; ++m) {
                bf16_t* rowp = ZT + (size_t)(row0 + ai * 128 + m * 16) * MT + col0;
#pragma unroll
                for (int bj = 0; bj < 2; ++bj) {
                    f32x4 v0 = acc[ai][bj][m][0] * rsv[bj][0], v1 = acc[ai][bj][m][1] * rsv[bj][1];
                    if (gel) {
#pragma unroll
                        for (int j = 0; j < 4; ++j) { v0[j] = gelu_t(v0[j]); v1[j] = gelu_t(v1[j]); } }
                    *(bf16x8*)(rowp + bj * 128) = pack8(v0, v1);
                }
            }
    }
};
struct MergeOrder : pg8::StaticOrder {
    __host__ __device__ bool next(int i, Unit& u) const { const int q = i / 3, seg = i - 3 * q; if (!pg8::StaticOrder::next(q, u)) return false; u.kt0 = seg == 0 ? 0 : (seg == 1 ? 8 : 24); u.nkt = seg == 1 ? 16 : 8; u.zero = seg == 2; return true; }
};
struct EpiMerge {
    static constexpr bool PERM = true, AFTER_DRAIN = false, HAS_MID = true;
    const bf16_t* Z; bf16_t* mergedb;
    __device__ __forceinline__ void mid(f32x4 (&acc)[2][2][4][2], const Unit& u, int wr, int wc, int fr, int fq) const {
        if (u.zero) { (*this)(acc, u, wr, wc, fr, fq); return; }
        const int which = u.kt0 == 0 ? 0 : 1;
        const int row0 = u.pm * 256 + wr * 64 + fr, col0 = u.pn * 256 + wc * 32 + 8 * fq;
#pragma unroll
        for (int ai = 0; ai < 2; ++ai)
#pragma unroll
            for (int mp = 0; mp < 2; ++mp) {
                u32x4 nu[2][2], de[2][2];
#pragma unroll
                for (int mm = 0; mm < 2; ++mm)
#pragma unroll
                    for (int bj = 0; bj < 2; ++bj) {
                        const bf16_t* gp = Z + (size_t)(row0 + ai * 128 + (2 * mp + mm) * 16) * NZ + ZG + which * 2048 + col0 + bj * 128;
                        nu[mm][bj] = *(const u32x4*)gp; de[mm][bj] = *(const u32x4*)(gp + 2048);
                    }
                asm volatile("" ::: "memory");
#pragma unroll
                for (int mm = 0; mm < 2; ++mm)
#pragma unroll
                    for (int bj = 0; bj < 2; ++bj) {
                        const u32x4 n_ = nu[mm][bj], d_ = de[mm][bj];
                        f32x4 r0, r1;
                        r0[0] = bflo(n_.x) * __builtin_amdgcn_rcpf(bflo(d_.x)); r0[1] = bfhi(n_.x) * __builtin_amdgcn_rcpf(bfhi(d_.x));
                        r0[2] = bflo(n_.y) * __builtin_amdgcn_rcpf(bflo(d_.y)); r0[3] = bfhi(n_.y) * __builtin_amdgcn_rcpf(bfhi(d_.y));
                        r1[0] = bflo(n_.z) * __builtin_amdgcn_rcpf(bflo(d_.z)); r1[1] = bfhi(n_.z) * __builtin_amdgcn_rcpf(bfhi(d_.z));
                        r1[2] = bflo(n_.w) * __builtin_amdgcn_rcpf(bflo(d_.w)); r1[3] = bfhi(n_.w) * __builtin_amdgcn_rcpf(bfhi(d_.w));
                        acc[ai][bj][2 * mp + mm][0] *= r0; acc[ai][bj][2 * mp + mm][1] *= r1;
                    }
            }
    }
    __device__ __forceinline__ void operator()(const f32x4 (&acc)[2][2][4][2], const Unit& u, int wr, int wc, int fr, int fq) const {
        const int row0 = u.pm * 256 + wr * 64 + fr, col0 = u.pn * 256 + wc * 32 + 8 * fq;
#pragma unroll
        for (int ai = 0; ai < 2; ++ai) {
            u32x4 gcv[4][2];
#pragma unroll
            for (int m = 0; m < 4; ++m)
#pragma unroll
                for (int bj = 0; bj < 2; ++bj) gcv[m][bj] = *(const u32x4*)(Z + (size_t)(row0 + ai * 128 + m * 16) * NZ + ZG + 2 * 2048 + col0 + bj * 128);
#pragma unroll
            for (int m = 0; m < 4; ++m) {
                const int row = row0 + ai * 128 + m * 16;
#pragma unroll
                for (int bj = 0; bj < 2; ++bj) {
                    const u32x4 gc = gcv[m][bj];
                    const f32x4 g0 = {bflo(gc.x), bfhi(gc.x), bflo(gc.y), bfhi(gc.y)}, g1 = {bflo(gc.z), bfhi(gc.z), bflo(gc.w), bfhi(gc.w)};
                    *(bf16x8*)(mergedb + (size_t)row * DM + col0 + bj * 128) = pack8(acc[ai][bj][m][0] * g0, acc[ai][bj][m][1] * g1);
                }
            }
        }
    }
};
template <int MODE> struct EpiRes {
    static constexpr bool PERM = true, AFTER_DRAIN = false, HAS_MID = false;
    static constexpr int NB = MODE == 1 ? 1 : 2;
    const float* base; float* out; bf16_t* xb; float* ssq_out; const float* ssq_in; const bf16_t* P;
    __device__ __forceinline__ void operator()(const f32x4 (&acc)[2][2][4][2], const Unit& u, int wr, int wc, int fr, int fq) const {
        const int row0 = u.pm * 256 + wr * 64 + fr, col0 = u.pn * 256 + wc * 32 + 8 * fq;
        float rsv[2][4];
        if (MODE == 1) {
#pragma unroll
            for (int ai = 0; ai < 2; ++ai)
#pragma unroll
                for (int m = 0; m < 4; ++m) rsv[ai][m] = row_rstd(ssq_in, row0 + ai * 128 + m * 16, fq);
        }
#pragma unroll
        for (int ai = 0; ai < 2; ++ai)
#pragma unroll
            for (int mp = 0; mp < 4 / NB; ++mp) {
                f32x4 bv[NB][2][2]; u32x4 pv[NB][2];
#pragma unroll
                for (int mm = 0; mm < NB; ++mm)
#pragma unroll
                    for (int bj = 0; bj < 2; ++bj) {
                        const size_t off = (size_t)(row0 + ai * 128 + (NB * mp + mm) * 16) * DM + col0 + bj * 128;
                        bv[mm][bj][0] = *(const f32x4*)(base + off); bv[mm][bj][1] = *(const f32x4*)(base + off + 4);
                        if (MODE == 1) pv[mm][bj] = *(const u32x4*)(P + off);
                    }
#pragma unroll
                for (int mm = 0; mm < NB; ++mm) {
                    const int m = NB * mp + mm, row = row0 + ai * 128 + m * 16;
                    float ss = 0.f;
#pragma unroll
                    for (int bj = 0; bj < 2; ++bj) {
                        const size_t off = (size_t)row * DM + col0 + bj * 128;
                        f32x4 d0 = acc[ai][bj][m][0], d1 = acc[ai][bj][m][1];
                        if (MODE == 1) { const u32x4 pw = pv[mm][bj];
                            const f32x4 p0 = {bflo(pw.x), bfhi(pw.x), bflo(pw.y), bfhi(pw.y)}, p1 = {bflo(pw.z), bfhi(pw.z), bflo(pw.w), bfhi(pw.w)};
#pragma unroll
                            for (int j = 0; j < 4; ++j) { d0[j] = sigm(d0[j] * rsv[ai][m]) * p0[j]; d1[j] = sigm(d1[j] * rsv[ai][m]) * p1[j]; } }
                        const f32x4 x0 = bv[mm][bj][0] + d0, x1 = bv[mm][bj][1] + d1;
                        *(f32x4*)(out + off) = x0; *(f32x4*)(out + off + 4) = x1;
                        if (xb) *(bf16x8*)(xb + off) = pack8(x0, x1);
                        ss += ((x0[0] * x0[0] + x0[1] * x0[1]) + (x0[2] * x0[2] + x0[3] * x0[3])) + ((x1[0] * x1[0] + x1[1] * x1[1]) + (x1[2] * x1[2] + x1[3] * x1[3]));
                    }
                    ss += __shfl_xor(ss, 16); ss += __shfl_xor(ss, 32);
                    if (fq == 0) ssq_out[(size_t)row * 32 + u.pn * 4 + wc] = ss;
                }
            }
    }
};
struct EpiUp {
    static constexpr bool PERM = true, AFTER_DRAIN = false, HAS_MID = false;
    bf16_t* H; const float* ssq;
    __device__ __forceinline__ void operator()(const f32x4 (&acc)[2][2][4][2], const Unit& u, int wr, int wc, int fr, int fq) const {
        const int row0 = u.pm * 256 + wr * 64 + fr, col0 = u.pn * 256 + wc * 32 + 8 * fq;
        float rsv[2][4];
#pragma unroll
        for (int ai = 0; ai < 2; ++ai)
#pragma unroll
            for (int m = 0; m < 4; ++m) rsv[ai][m] = row_rstd(ssq, row0 + ai * 128 + m * 16, fq);
#pragma unroll
        for (int ai = 0; ai < 2; ++ai)
#pragma unroll
            for (int m = 0; m < 4; ++m) {
                const int row = row0 + ai * 128 + m * 16;
                const float rs = rsv[ai][m];
                bf16_t* rowp = H + (size_t)row * FF + col0;
#pragma unroll
                for (int bj = 0; bj < 2; ++bj) {
                    f32x4 v0 = acc[ai][bj][m][0] * rs, v1 = acc[ai][bj][m][1] * rs;
#pragma unroll
                    for (int j = 0; j < 4; ++j) { const float a = fmaxf(v0[j], 0.f), b = fmaxf(v1[j], 0.f); v0[j] = a * a; v1[j] = b * b; }
                    *(bf16x8*)(rowp + bj * 128) = pack8(v0, v1);
                }
            }
    }
};
struct EpiP {
    static constexpr bool PERM = true, AFTER_DRAIN = false, HAS_MID = false;
    bf16_t* O; int ldc;
    __device__ __forceinline__ void operator()(const f32x4 (&acc)[2][2][4][2], const Unit& u, int wr, int wc, int fr, int fq) const {
        const int row0 = u.pm * 256 + wr * 64 + fr, col0 = u.pn * 256 + wc * 32 + 8 * fq;
#pragma unroll
        for (int ai = 0; ai < 2; ++ai)
#pragma unroll
            for (int m = 0; m < 4; ++m) {
                bf16_t* rowp = O + (size_t)(row0 + ai * 128 + m * 16) * ldc + col0;
#pragma unroll
                for (int bj = 0; bj < 2; ++bj) *(bf16x8*)(rowp + bj * 128) = pack8(acc[ai][bj][m][0], acc[ai][bj][m][1]);
            }
    }
};

template <class Epi, class Order = pg8::StaticOrder> __device__ __forceinline__ void run_gemm(LAS unsigned char* lds, const bf16_t* A, const bf16_t* Bt, int M, int N, int K, const Epi& E) {
    __syncthreads();
    pg8::Gemm g{A, Bt, M, N, K}; Order S; S.init(M, N, (int)gridDim.x, (int)blockIdx.x, K);
    pg8::gemm_phase<Epi, Order, false>(lds, g, S, E, nullptr);
    __syncthreads();
}

struct CvtSeg { const float* src; int ld; const float* gain; bf16_t* dst; int K, N, ldd; };
constexpr int CVT_TILES_L = 4384, CVT_TILES = 2 * CVT_TILES_L;
__device__ __forceinline__ CvtSeg cvt_get(const Params& p, int gt, int& lt) {
    const int l = gt >= CVT_TILES_L ? 1 : 0; int t = gt - l * CVT_TILES_L;
    const float* win = p.in[3] + (size_t)l * 2048 * WIN_LD; bf16_t* wti = ((bf16_t*)(p.ws + OFF_wt_in)) + (size_t)l * NWIN * 2048; const float* gm = p.in[2] + l * 2048;
    bf16_t* wcat = ((bf16_t*)(p.ws + OFF_wt_a)) + (size_t)l * 2048 * 2048;
#define CVT_SEG(NT, ...) if (t < (NT)) { lt = t; return CvtSeg{__VA_ARGS__}; } t -= (NT);
    CVT_SEG(64,  win + 0,    WIN_LD, gm, wti + (size_t)0 * 2048,     2048, 512, 2048)
    CVT_SEG(64,  win + 512,  WIN_LD, gm, wti + (size_t)512 * 2048,   2048, 512, 2048)
    CVT_SEG(64,  win + 1536, WIN_LD, gm, wti + (size_t)1024 * 2048,  2048, 512, 2048)
    CVT_SEG(128, win + 2056, WIN_LD, gm, wti + (size_t)1536 * 2048,  2048, 1024, 2048)
    CVT_SEG(128, win + 3080, WIN_LD, gm, wti + (size_t)2560 * 2048,  2048, 1024, 2048)
    CVT_SEG(64,  win + 5128, WIN_LD, gm, wti + (size_t)3584 * 2048,  2048, 512, 2048)
    CVT_SEG(768, win + 6152, WIN_LD, gm, wti + (size_t)4096 * 2048,  2048, 6144, 2048)
    CVT_SEG(64,  win + 1024, WIN_LD, gm, wti + (size_t)10240 * 2048, 2048, 512, 2048)
    CVT_SEG(128, win + 4104, WIN_LD, gm, wti + (size_t)10752 * 2048, 2048, 1024, 2048)
    CVT_SEG(64,  win + 5640, WIN_LD, gm, wti + (size_t)11776 * 2048, 2048, 512, 2048)
    CVT_SEG(64,  p.in[10] + (size_t)l * 512 * 2048,  2048, nullptr, wcat + 0,    512, 2048, 2048)
    CVT_SEG(128, p.in[11] + (size_t)l * 1024 * 2048, 2048, nullptr, wcat + 512,  1024, 2048, 2048)
    CVT_SEG(64,  p.in[12] + (size_t)l * 512 * 2048,  2048, nullptr, wcat + 1536, 512, 2048, 2048)
    CVT_SEG(256, p.in[13] + (size_t)l * 2048 * 2048, 2048, nullptr, ((bf16_t*)(p.ws + OFF_wt_out)) + (size_t)l * 2048 * 2048, 2048, 2048, 2048)
    CVT_SEG(1024, p.in[15] + (size_t)l * 2048 * 8192, 8192, p.in[14] + l * 2048, ((bf16_t*)(p.ws + OFF_wt_up)) + (size_t)l * 8192 * 2048, 2048, 8192, 2048)
    CVT_SEG(1024, p.in[16] + (size_t)l * 8192 * 2048, 2048, nullptr, ((bf16_t*)(p.ws + OFF_wt_down)) + (size_t)l * 2048 * 8192, 8192, 2048, 8192)
    CVT_SEG(256, p.in[18] + (size_t)l * 2048 * 2048, 2048, p.in[17] + l * 2048, ((bf16_t*)(p.ws + OFF_wt_pg)) + (size_t)l * 2048 * 2048, 2048, 2048, 2048)
#undef CVT_SEG
    lt = t; return CvtSeg{p.in[19] + (size_t)l * 256 * 2048, 2048, nullptr, ((bf16_t*)(p.ws + OFF_wt_pe)) + (size_t)l * 2048 * 256, 256, 2048, 256};
}
__device__ __forceinline__ void cvt_load(const CvtSeg& sg, int t, int tid, f32x4 (&r)[8]) {
    const int nnt = sg.N >> 8, q_ = t >> 2; const int kt = (q_ / nnt) * 4 + (t & 3), nt = q_ % nnt;
    const float* base = sg.src + (size_t)(kt * 64 + (tid >> 6)) * sg.ld + nt * 256 + (tid & 63) * 4;
#pragma unroll
    for (int i = 0; i < 8; ++i) r[i] = __builtin_nontemporal_load((const f32x4*)(base + (size_t)(8 * i) * sg.ld));
}
__device__ __forceinline__ void cvt_step(const Params& p, LAS bf16_t* T, CvtSeg& sg, int& lt, f32x4 (&r)[8], int gnext, int tid) {
    const int nnt = sg.N >> 8, q_ = lt >> 2; const int kt = (q_ / nnt) * 4 + (lt & 3), nt = q_ % nnt;
#pragma unroll
    for (int i = 0; i < 8; ++i) { const int k = (tid >> 6) + 8 * i; f32x4 v = r[i]; if (sg.gain) v = v * sg.gain[kt * 64 + k];
        const u32x2 w = pack4(v); LAS unsigned* q = (LAS unsigned*)(T + k * 258 + (tid & 63) * 4); q[0] = w.x; q[1] = w.y; }
    bf16_t* const dst = sg.dst; const int ldd = sg.ldd;
    __syncthreads();
    if (gnext < CVT_TILES) { sg = cvt_get(p, gnext, lt); cvt_load(sg, lt, tid, r); }
#pragma unroll
    for (int j = 0; j < 4; ++j) { const int n = (tid >> 3) + 64 * j, kc = (tid & 7) * 8;
        unsigned short e[8];
#pragma unroll
        for (int q = 0; q < 8; ++q) e[q] = T[(kc + q) * 258 + n];
        u32x4 w; w.x = e[0] | ((unsigned)e[1] << 16); w.y = e[2] | ((unsigned)e[3] << 16); w.z = e[4] | ((unsigned)e[5] << 16); w.w = e[6] | ((unsigned)e[7] << 16);
        *(u32x4*)(dst + (size_t)(nt * 256 + n) * ldd + kt * 64 + kc) = w; }
    __syncthreads();
}
__device__ __forceinline__ void cvt_all(const Params& p, LAS unsigned char* lds, int tid) {
    LAS bf16_t* T = (LAS bf16_t*)lds;
    const int G = gridDim.x, bid = blockIdx.x;
#define CVT_GT(i) (4 * (bid + ((i) >> 2) * G) + ((i) & 3))
    f32x4 ra[8], rb[8]; CvtSeg sa, sb; int la = 0, lb = 0;
    sa = cvt_get(p, CVT_GT(0) < CVT_TILES ? CVT_GT(0) : 0, la); sb = cvt_get(p, CVT_GT(1) < CVT_TILES ? CVT_GT(1) : 0, lb);
    if (CVT_GT(0) < CVT_TILES) cvt_load(sa, la, tid, ra);
    if (CVT_GT(1) < CVT_TILES) cvt_load(sb, lb, tid, rb);
    for (int i = 0; CVT_GT(i) < CVT_TILES; i += 2) {
        cvt_step(p, T, sa, la, ra, CVT_GT(i + 2), tid);
        if (CVT_GT(i + 1) < CVT_TILES) cvt_step(p, T, sb, lb, rb, CVT_GT(i + 3), tid);
    }
#undef CVT_GT
}
__device__ __forceinline__ void prologue(const Params& p, LAS unsigned char* lds, int tid) {
    const int gid = blockIdx.x * 512 + tid, gsz = gridDim.x * 512;
    for (int i = gid; i < SEQ * 16; i += gsz) {
        const int pos = i >> 4, j = i & 15;
        const float inv = exp2f(-(float)j * (1.0f / 16.0f) * 18.931568569324174f);
        const float ang = (float)pos * inv;
        const double rev = (double)ang * 0.15915494309189535;
        const float fr = (float)(rev - floor(rev));
        ((float*)(p.ws + OFF_rope))[2 * i] = __builtin_amdgcn_cosf(fr); ((float*)(p.ws + OFF_rope))[2 * i + 1] = __builtin_amdgcn_sinf(fr);
    }
    for (int i = gid; i < 2 * 2048 * 8; i += gsz) { const int l = i >> 14, k = (i >> 3) & 2047, j = i & 7; ((float*)(p.ws + OFF_gw))[i] = p.in[3][((size_t)l * 2048 + k) * WIN_LD + 2048 + j] * p.in[2][l * 2048 + k]; }
    for (int i = gid; i < 2 * MT * 256 / 4; i += gsz) { const f32x4 v = ((const f32x4*)p.in[1])[i]; ((u32x2*)((bf16_t*)(p.ws + OFF_pb)))[i] = pack4(v); }
    { const int lane = tid & 63, w = tid >> 6;
      for (int row = blockIdx.x * 8 + w; row < MT; row += gridDim.x * 8) {
          float ss = 0.f;
#pragma unroll
          for (int i = 0; i < 8; ++i) { const int k = 4 * lane + 256 * i; const f32x4 v = *(const f32x4*)(p.in[0] + (size_t)row * DM + k); ss += (v[0] * v[0] + v[1] * v[1]) + (v[2] * v[2] + v[3] * v[3]); *(u32x2*)(((bf16_t*)(p.ws + OFF_xb0)) + (size_t)row * DM + k) = pack4(v); }
          ss = wave_sum(ss);
          if (lane < 32) ((float*)(p.ws + OFF_ssq0))[(size_t)row * 32 + lane] = lane == 0 ? ss : 0.f;
      } }
    cvt_all(p, lds, tid);
}

__device__ __forceinline__ void gates_phase(const Params& p, int layer, const float* xsrc, int tid) {
    const int lane = tid & 63, w = tid >> 6;
    const float* gwt = ((float*)(p.ws + OFF_gw)) + (size_t)layer * 2048 * 8;
    for (int r0 = blockIdx.x * 8 + w; r0 < 2048; r0 += gridDim.x * 8) {
        float acc[4][8]; float ss[4];
#pragma unroll
        for (int i = 0; i < 4; ++i) { ss[i] = 0.f;
#pragma unroll
            for (int j = 0; j < 8; ++j) acc[i][j] = 0.f; }
        for (int kk = 0; kk < 8; ++kk) {
            const int k = 4 * lane + 256 * kk;
            f32x4 xv[4];
#pragma unroll
            for (int i = 0; i < 4; ++i) { xv[i] = *(const f32x4*)(xsrc + (size_t)(r0 + 2048 * i) * DM + k); ss[i] += (xv[i][0] * xv[i][0] + xv[i][1] * xv[i][1]) + (xv[i][2] * xv[i][2] + xv[i][3] * xv[i][3]); }
#pragma unroll
            for (int kq = 0; kq < 4; ++kq) {
                const f32x4 w0 = *(const f32x4*)(gwt + (size_t)(k + kq) * 8), w1 = *(const f32x4*)(gwt + (size_t)(k + kq) * 8 + 4);
#pragma unroll
                for (int i = 0; i < 4; ++i) { const float xx = xv[i][kq];
#pragma unroll
                    for (int j = 0; j < 4; ++j) { acc[i][j] += xx * w0[j]; acc[i][4 + j] += xx * w1[j]; } }
            }
        }
#pragma unroll
        for (int i = 0; i < 4; ++i) {
            const float rs = rsqrtf(wave_sum(ss[i]) * (1.0f / 2048.0f) + 1e-6f);
            float outv = 0.f;
#pragma unroll
            for (int j = 0; j < 8; ++j) { const float v = wave_sum(acc[i][j]); if (lane == j) outv = v * rs + p.in[4][layer * 8 + j]; }
            if (lane < 8) ((float*)(p.ws + OFF_GT))[(size_t)(r0 + 2048 * i) * 8 + lane] = outv;
        }
    }
}

__device__ __forceinline__ void mlstm_a_unit(const Params& p, LAS unsigned char* lds, int unit, int tid) {
    const int bh = unit >> 6, c = unit & 63, b = bh >> 2, h = bh & 3;
    const int tok0 = b * SEQ + c * 64;
    const int lane = tid & 63, w = tid >> 6, fr = lane & 15, g4 = lane >> 4;
    LAS bf16_t* KT = (LAS bf16_t*)lds;
    const bf16_t* vt = ((bf16_t*)(p.ws + OFF_ZT)) + (size_t)(TVA + h * 128 + 16 * w + fr) * MT + tok0 + 8 * g4;
    const bf16x8 A0 = *(const bf16x8*)vt, A1 = *(const bf16x8*)(vt + 32);
    const float ig = ((float*)(p.ws + OFF_GT))[(size_t)(tok0 + lane) * 8 + h], fp = ((float*)(p.ws + OFF_GT))[(size_t)(tok0 + lane) * 8 + 4 + h];
    const float g = wave_scan_add(log_sigmoid(fp), lane);
    const float glast = __shfl(g, 63);
    const float lu = glast - g + ig;
    const float mloc = wave_max(lu);
    const float uu = expf(lu - mloc);
    { const int l = tid >> 3, kc = (tid & 7) * 16;
      const float ul = __shfl(uu, l);
      const u32x4* src = (const u32x4*)(((bf16_t*)(p.ws + OFF_Z)) + (size_t)(tok0 + l) * NZ + ZKA + h * 128 + kc);
      const u32x4 a = src[0], bq = src[1];
      const unsigned wd[8] = {a.x, a.y, a.z, a.w, bq.x, bq.y, bq.z, bq.w};
#pragma unroll
      for (int e = 0; e < 8; ++e) { KT[(kc + 2 * e) * 72 + l] = f2bf(bflo(wd[e]) * ul); KT[(kc + 2 * e + 1) * 72 + l] = f2bf(bfhi(wd[e]) * ul); } }
    __syncthreads();
    if (tid < 128) {
        float s = 0.f; const LAS bf16x8* r = (const LAS bf16x8*)(KT + tid * 72);
#pragma unroll
        for (int i = 0; i < 8; ++i) { const bf16x8 v = r[i];
#pragma unroll
            for (int e = 0; e < 8; ++e) s += bf2f((bf16_t)v[e]); }
        ((float*)(p.ws + OFF_dn))[((size_t)bh * 64 + c) * 128 + tid] = s;
    }
    f32x4 acc[8];
#pragma unroll
    for (int kt = 0; kt < 8; ++kt) acc[kt] = (f32x4){0.f, 0.f, 0.f, 0.f};
#pragma unroll
    for (int kt = 0; kt < 8; ++kt) {
        const LAS bf16_t* kb = KT + (16 * kt + fr) * 72 + 8 * g4;
        const bf16x8 B0 = *(const LAS bf16x8*)kb, B1 = *(const LAS bf16x8*)(kb + 32);
        acc[kt] = mfma16(A0, B0, acc[kt]); acc[kt] = mfma16(A1, B1, acc[kt]);
    }
    float* dst = ((float*)(p.ws + OFF_dC)) + ((size_t)bh * 64 + c) * 16384;
#pragma unroll
    for (int kt = 0; kt < 8; ++kt)
#pragma unroll
        for (int j = 0; j < 4; ++j) dst[(16 * w + 4 * g4 + j) * 128 + 16 * kt + fr] = acc[kt][j];
    if (tid == 0) { ((float*)(p.ws + OFF_gsc))[(bh * 64 + c) * 2] = glast; ((float*)(p.ws + OFF_gsc))[(bh * 64 + c) * 2 + 1] = mloc; }
    __syncthreads();
}
__device__ __forceinline__ void mlstm_scan(const Params& p, int tid) {
    const int total = 8 * 16512, lane = tid & 63;
    for (int e = blockIdx.x * 512 + tid; e < total; e += gridDim.x * 512) {
        const int bh = e / 16512, r = e - bh * 16512;
        const float gl = ((float*)(p.ws + OFF_gsc))[(bh * 64 + lane) * 2], ml = ((float*)(p.ws + OFF_gsc))[(bh * 64 + lane) * 2 + 1];
        const float G = wave_scan_add(gl, lane);
        const float mc = G + fmaxf(0.f, wave_scan_max(ml - G, lane));
        float mp = __shfl_up(mc, 1); if (lane == 0) mp = 0.f;
        const float ca = expf(gl + mp - mc), cb = expf(ml - mc);
        if (r == lane) ((float*)(p.ws + OFF_mprev))[bh * 64 + lane] = mp;
        const bool isC = r < 16384;
        const float* src = isC ? ((float*)(p.ws + OFF_dC)) + (size_t)bh * 64 * 16384 + r : ((float*)(p.ws + OFF_dn)) + (size_t)bh * 64 * 128 + (r - 16384);
        const int stride = isC ? 16384 : 128;
        float dv[64];
#pragma unroll
        for (int c = 0; c < 64; ++c) dv[c] = src[(size_t)c * stride];
        float st = 0.f;
#pragma unroll
        for (int c = 0; c < 64; ++c) {
            if (isC) ((bf16_t*)(p.ws + OFF_Cprev))[((size_t)bh * 64 + c) * 16384 + r] = f2bf(st); else ((float*)(p.ws + OFF_nprev))[((size_t)bh * 64 + c) * 128 + (r - 16384)] = st;
            st = __shfl(ca, c) * st + __shfl(cb, c) * dv[c];
        }
    }
}
__device__ __forceinline__ void mlstm_c_unit(const Params& p, LAS unsigned char* lds, int unit, int tid, int layer) {
    const int bh = unit >> 6, c = unit & 63, b = bh >> 2, h = bh & 3;
    const int tok0 = b * SEQ + c * 64;
    const int lane = tid & 63, w = tid >> 6, fr = lane & 15, g4 = lane >> 4;
    LAS float* sE = (LAS float*)lds; LAS float* sD = sE + 64; LAS float* sMr = sE + 128; LAS float* sSS = sE + 192;
    const float m0 = ((float*)(p.ws + OFF_mprev))[bh * 64 + c];
    const int lt = w & 3, vh = w >> 2;
    const int l = 16 * lt + fr;
    const bf16_t* qp = ((bf16_t*)(p.ws + OFF_Z)) + (size_t)(tok0 + l) * NZ + ZQA + h * 128 + 8 * g4;
    bf16x8 Q[4];
#pragma unroll
    for (int ks = 0; ks < 4; ++ks) Q[ks] = *(const bf16x8*)(qp + 32 * ks);
    if (w == 0) {
        const float ig = ((float*)(p.ws + OFF_GT))[(size_t)(tok0 + lane) * 8 + h], fp = ((float*)(p.ws + OFF_GT))[(size_t)(tok0 + lane) * 8 + 4 + h];
        const float g = wave_scan_add(log_sigmoid(fp), lane);
        const float d = ig - g;
        const float bm = wave_scan_max(d, lane);
        const float mrow = g + fmaxf(bm, m0);
        sE[lane] = g - mrow; sD[lane] = d; sMr[lane] = mrow;
    }
    __syncthreads();
    const float el = sE[l];
    f32x4 pv[4]; float dsum = 0.f;
#pragma unroll
    for (int st = 0; st < 4; ++st) {
        pv[st] = (f32x4){0.f, 0.f, 0.f, 0.f};
        if (st <= lt) {
            const bf16_t* kp = ((bf16_t*)(p.ws + OFF_Z)) + (size_t)(tok0 + 16 * st + fr) * NZ + ZKA + h * 128 + 8 * g4;
            f32x4 s = {0.f, 0.f, 0.f, 0.f};
#pragma unroll
            for (int ks = 0; ks < 4; ++ks) s = mfma16(*(const bf16x8*)(kp + 32 * ks), Q[ks], s);
#pragma unroll
            for (int j = 0; j < 4; ++j) { const int sidx = 16 * st + 4 * g4 + j; const float wgt = (sidx <= l) ? s[j] * expf(el + sD[sidx]) : 0.f; pv[st][j] = wgt; dsum += wgt; }
        }
    }
    dsum += __shfl_xor(dsum, 16); dsum += __shfl_xor(dsum, 32);
    bf16x8 PB[2]; PB[0] = pack8(pv[0], pv[1]); PB[1] = pack8(pv[2], pv[3]);
    float qn = 0.f;
    { const float* np = ((float*)(p.ws + OFF_nprev)) + ((size_t)bh * 64 + c) * 128 + 8 * g4;
#pragma unroll
      for (int ks = 0; ks < 4; ++ks) { const f32x4 n0 = *(const f32x4*)(np + 32 * ks), n1 = *(const f32x4*)(np + 32 * ks + 4);
#pragma unroll
          for (int e = 0; e < 4; ++e) { qn += n0[e] * bf2f((bf16_t)Q[ks][e]); qn += n1[e] * bf2f((bf16_t)Q[ks][4 + e]); } } }
    qn += __shfl_xor(qn, 16); qn += __shfl_xor(qn, 32);
    const float al = expf(el + m0);
    const float den = dsum + al * qn;
    const float inv = 1.0f / fmaxf(fabsf(den), expf(-sMr[l]));
    f32x4 hv[4]; float ss = 0.f;
    const bf16_t* cp = ((bf16_t*)(p.ws + OFF_Cprev)) + ((size_t)bh * 64 + c) * 16384;
#pragma unroll
    for (int vt = 0; vt < 4; ++vt) {
        const int vrow = 64 * vh + 16 * vt + fr;
        f32x4 nacc = {0.f, 0.f, 0.f, 0.f}, iacc = {0.f, 0.f, 0.f, 0.f};
        const bf16_t* vp = ((bf16_t*)(p.ws + OFF_ZT)) + (size_t)(TVA + h * 128 + vrow) * MT + tok0 + 4 * g4;
#pragma unroll
        for (int kk = 0; kk < 2; ++kk) if (2 * kk <= lt) { const bf16x4 a0 = *(const bf16x4*)(vp + 32 * kk), a1 = *(const bf16x4*)(vp + 32 * kk + 16); nacc = mfma16(cat4(a0, a1), PB[kk], nacc); }
        const bf16_t* cr = cp + (size_t)vrow * 128 + 8 * g4;
#pragma unroll
        for (int ks = 0; ks < 4; ++ks) iacc = mfma16(*(const bf16x8*)(cr + 32 * ks), Q[ks], iacc);
#pragma unroll
        for (int j = 0; j < 4; ++j) { const float hh = (nacc[j] + al * iacc[j]) * inv; hv[vt][j] = hh; ss += hh * hh; }
    }
    ss += __shfl_xor(ss, 16); ss += __shfl_xor(ss, 32);
    if (g4 == 0) sSS[w * 16 + fr] = ss;
    __syncthreads();
    const float tot = ss + sSS[(w ^ 4) * 16 + fr];
    const float rn = rsqrtf(tot * (1.0f / 128.0f) + 1e-6f);
#pragma unroll
    for (int vt = 0; vt < 4; ++vt) {
        const int v0 = 64 * vh + 16 * vt + 4 * g4;
        const f32x4 ng = *(const f32x4*)(p.in[5] + layer * 512 + h * 128 + v0);
        const f32x4 so = unpack4(*(const u32x2*)(((bf16_t*)(p.ws + OFF_Z)) + (size_t)(tok0 + l) * NZ + ZOA + h * 128 + v0));
        f32x4 y;
#pragma unroll
        for (int j = 0; j < 4; ++j) y[j] = hv[vt][j] * rn * ng[j] * so[j];
        *(u32x2*)(((bf16_t*)(p.ws + OFF_yA)) + (size_t)(tok0 + l) * 2048 + h * 128 + v0) = pack4(y);
    }
    __syncthreads();
}

__device__ __forceinline__ void kmean_unit(const Params& p, LAS unsigned char* lds, int unit, int tid) {
    const int bh = unit >> 4, j = unit & 15, b = bh >> 3, h = bh & 7;
    LAS float* red = (LAS float*)lds;
    const int dc = tid & 15, kg = tid >> 4;
    float a[8];
#pragma unroll
    for (int e = 0; e < 8; ++e) a[e] = 0.f;
    const bf16_t* src = ((bf16_t*)(p.ws + OFF_Z)) + (size_t)(b * SEQ + j * 256 + kg * 8) * NZ + ZKB + h * 128 + dc * 8;
#pragma unroll
    for (int i = 0; i < 8; ++i) { const u32x4 v = *(const u32x4*)(src + (size_t)i * NZ);
        a[0] += bflo(v.x); a[1] += bfhi(v.x); a[2] += bflo(v.y); a[3] += bfhi(v.y); a[4] += bflo(v.z); a[5] += bfhi(v.z); a[6] += bflo(v.w); a[7] += bfhi(v.w); }
#pragma unroll
    for (int e = 0; e < 8; ++e) red[kg * 128 + dc * 8 + e] = a[e];
    __syncthreads();
    if (tid < 128) { float s = 0.f;
#pragma unroll 8
        for (int g = 0; g < 32; ++g) s += red[g * 128 + tid];
        ((float*)(p.ws + OFF_kmean))[((size_t)bh * 16 + j) * 128 + tid] = s * (1.0f / 256.0f); }
    __syncthreads();
}
constexpr float MOBA_SC = 0.08838834764831845f * 1.4426950408889634f;
__device__ __forceinline__ void moba_gate_unit(const Params& p, LAS unsigned char* lds, int unit, int tid) {
    const int bh = unit >> 5, tile = unit & 31, b = bh >> 3, h = bh & 7, ib = tile >> 1;
    const int lane = tid & 63;
    LAS float* sKm = (LAS float*)lds;
    for (int i = tid; i < 2048; i += 512) sKm[(i >> 7) * 132 + (i & 127)] = ((float*)(p.ws + OFF_kmean))[(size_t)bh * 2048 + i];
    __syncthreads();
    const int row = tid >> 2, jq = tid & 3;
    const int srow = tile * 128 + row;
    const bf16_t* qp = ((bf16_t*)(p.ws + OFF_Z)) + (size_t)(b * SEQ + srow) * NZ + ZQB + h * 128;
    float sc4[4] = {0.f, 0.f, 0.f, 0.f};
    for (int d8 = 0; d8 < 16; ++d8) {
        const u32x4 qv = *(const u32x4*)(qp + 8 * d8);
        const f32x4 q0 = {bflo(qv.x), bfhi(qv.x), bflo(qv.y), bfhi(qv.y)}, q1 = {bflo(qv.z), bfhi(qv.z), bflo(qv.w), bfhi(qv.w)};
#pragma unroll
        for (int m = 0; m < 4; ++m) { const LAS float* km = sKm + (4 * m + jq) * 132 + 8 * d8; const f32x4 k0 = *(const LAS f32x4*)km, k1 = *(const LAS f32x4*)(km + 4);
            sc4[m] += (q0[0] * k0[0] + q0[1] * k0[1]) + (q0[2] * k0[2] + q0[3] * k0[3]) + (q1[0] * k1[0] + q1[1] * k1[1]) + (q1[2] * k1[2] + q1[3] * k1[3]); }
    }
    float sc[16];
#pragma unroll
    for (int m = 0; m < 4; ++m)
#pragma unroll
        for (int qq = 0; qq < 4; ++qq) sc[4 * m + qq] = __shfl(sc4[m], (lane & ~3) | qq);
    unsigned mask = 0;
#pragma unroll
    for (int r = 0; r < 3; ++r) { float best = -3.0e38f; int bi = -1;
#pragma unroll
        for (int j = 0; j < 16; ++j) if (j < ib && !((mask >> j) & 1u) && sc[j] > best) { best = sc[j]; bi = j; }
        if (bi >= 0) mask |= 1u << bi; }
    if (jq == 0) ((unsigned*)(p.ws + OFF_selm))[(size_t)bh * SEQ + srow] = mask;
    unsigned basev[15];
#pragma unroll
    for (int j = 0; j < 15; ++j) {
        basev[j] = 0u;
        if (j < ib) {
            const bool mine = (jq == 0) && ((mask >> j) & 1u);
            const unsigned long long bal = __ballot(mine ? 1 : 0);
            if (bal != 0ull && lane == __ffsll((long long)bal) - 1) basev[j] = atomicAdd(((unsigned*)(p.ws + OFF_cnt)) + bh * 16 + j, (unsigned)__popcll(bal));
        }
    }
#pragma unroll
    for (int j = 0; j < 15; ++j) {
        if (j < ib) {
            const bool mine = (jq == 0) && ((mask >> j) & 1u);
            const unsigned long long bal = __ballot(mine ? 1 : 0);
            if (bal != 0ull) {
                const unsigned base = __shfl(basev[j], __ffsll((long long)bal) - 1);
                if (mine) { const int rank = __popcll(bal & ((1ull << lane) - 1ull)); ((unsigned short*)(p.ws + OFF_list))[(size_t)(bh * 16 + j) * 4096 + base + rank] = (unsigned short)srow; }
            }
        }
    }
    __syncthreads();
}
template <bool OWN> __device__ __forceinline__ void moba_unit_body(const LAS bf16_t* Kb, const LAS bf16_t* Vb, const bf16x8 (&Q)[2][4], const int (&rowi)[2], int j, int ktn, int fr, int g4,
                                                                   f32x4 (&O)[2][8], float (&mrun)[2], float (&lrun)[2]) {
    for (int kt = 0; kt < ktn; ++kt) {
        const int key0 = j * 256 + kt * 64;
        const LAS bf16_t* Kc = Kb + (64 * kt) * 136 + fr * 136 + 8 * g4; const LAS bf16_t* Vc = Vb + 64 * kt + fr * 264 + 4 * g4;
        f32x4 S[2][4];
        bf16x8 kf[2][4];
#pragma unroll
        for (int ks = 0; ks < 4; ++ks) kf[0][ks] = *(const LAS bf16x8*)(Kc + 32 * ks);
#pragma unroll
        for (int st = 0; st < 4; ++st) {
            if (st < 3) {
#pragma unroll
                for (int ks = 0; ks < 4; ++ks) kf[(st + 1) & 1][ks] = *(const LAS bf16x8*)(Kc + (16 * (st + 1)) * 136 + 32 * ks);
            }
            S[0][st] = (f32x4){0.f, 0.f, 0.f, 0.f}; S[1][st] = S[0][st];
#pragma unroll
            for (int ks = 0; ks < 4; ++ks) { S[0][st] = mfma16(kf[st & 1][ks], Q[0][ks], S[0][st]); S[1][st] = mfma16(kf[st & 1][ks], Q[1][ks], S[1][st]); }
        }
        bf16x4 vf[2][4];
#pragma unroll
        for (int q = 0; q < 4; ++q) vf[0][q] = *(const LAS bf16x4*)(Vc + 16 * q);
        bf16x8 PB[2][2];
#pragma unroll
        for (int cg = 0; cg < 2; ++cg) {
            float mx = -1.0e30f;
#pragma unroll
            for (int st = 0; st < 4; ++st)
#pragma unroll
                for (int jj = 0; jj < 4; ++jj) {
                    if (OWN) { const int key = key0 + 16 * st + 4 * g4 + jj; S[cg][st][jj] = (key <= rowi[cg]) ? S[cg][st][jj] : -1.0e30f; }
                    mx = fmaxf(mx, S[cg][st][jj]); }
            mx = fmaxf(mx, __shfl_xor(mx, 16)); mx = fmaxf(mx, __shfl_xor(mx, 32));
            const float mnew = fmaxf(mrun[cg], mx);
            const float alpha = ex2(mrun[cg] - mnew);
            float psum = 0.f;
#pragma unroll
            for (int st = 0; st < 4; ++st)
#pragma unroll
                for (int jj = 0; jj < 4; ++jj) { float pe = ex2(S[cg][st][jj] - mnew); if (OWN) pe = (S[cg][st][jj] > -1.0e29f) ? pe : 0.f; S[cg][st][jj] = pe; psum += pe; }
            lrun[cg] = lrun[cg] * alpha + psum; mrun[cg] = mnew;
#pragma unroll
            for (int dt = 0; dt < 8; ++dt) O[cg][dt] *= alpha;
            PB[cg][0] = pack8(S[cg][0], S[cg][1]); PB[cg][1] = pack8(S[cg][2], S[cg][3]);
        }
#pragma unroll
        for (int dt = 0; dt < 8; ++dt) {
            if (dt < 7) {
#pragma unroll
                for (int q = 0; q < 4; ++q) vf[(dt + 1) & 1][q] = *(const LAS bf16x4*)(Vc + (16 * (dt + 1)) * 264 + 16 * q);
            }
#pragma unroll
            for (int kk = 0; kk < 2; ++kk) { const bf16x8 v8 = cat4(vf[dt & 1][2 * kk], vf[dt & 1][2 * kk + 1]);
                O[0][dt] = mfma16(v8, PB[0][kk], O[0][dt]); O[1][dt] = mfma16(v8, PB[1][kk], O[1][dt]); }
        }
    }
}
__device__ __forceinline__ void moba_attn_phase(const Params& p, LAS unsigned char* lds, int tid) {
    const int lane = tid & 63, w = tid >> 6, fr = lane & 15, g4 = lane >> 4;
    LAS int* sPre = (LAS int*)lds;
    LAS bf16_t* Kb = (LAS bf16_t*)(lds + 2048);
    LAS bf16_t* Vb = (LAS bf16_t*)(lds + 2048 + 69632);
    const unsigned* cntp = (const unsigned*)(p.ws + OFF_cnt);
    if (tid < 256) sPre[tid + 1] = 1 + (int)((cntp[tid] + 255u) >> 8);
    if (tid == 0) sPre[0] = 0;
    __syncthreads();
    if (tid < 64) {
        int v0 = sPre[4 * lane + 1], v1 = sPre[4 * lane + 2], v2 = sPre[4 * lane + 3], v3 = sPre[4 * lane + 4];
        v1 += v0; v2 += v1; v3 += v2;
        int tot = v3;
#pragma unroll
        for (int o = 1; o < 64; o <<= 1) { const int t = __shfl_up(tot, o); if (lane >= o) tot += t; }
        const int excl = tot - v3;
        sPre[4 * lane + 1] = v0 + excl; sPre[4 * lane + 2] = v1 + excl; sPre[4 * lane + 3] = v2 + excl; sPre[4 * lane + 4] = v3 + excl;
    }
    __syncthreads();
    const int nunits = sPre[256];
    const int G_ = gridDim.x, b_ = blockIdx.x, lid_ = (G_ & 7) ? b_ : (b_ & 7) * (G_ >> 3) + (b_ >> 3);
    const int u0 = (int)(((long)lid_ * nunits) / G_), u1 = (int)(((long)(lid_ + 1) * nunits) / G_);
    int cur_bhj = -1;
    for (int u = u0; u < u1; ++u) {
        int lo = 0, hi = 256;
        while (hi - lo > 1) { const int mid = (lo + hi) >> 1; if (sPre[mid] <= u) lo = mid; else hi = mid; }
        const int bhj = lo, c = u - sPre[lo];
        const int bh = bhj >> 4, j = bhj & 15, b = bh >> 3, h = bh & 7;
        if (bhj != cur_bhj) {
            __syncthreads();
            u32x4 rk[8], rv[8];
            const bf16_t* kg = ((bf16_t*)(p.ws + OFF_Z)) + (size_t)(b * SEQ + j * 256 + (tid >> 4)) * NZ + ZKB + h * 128 + (tid & 15) * 8;
            const bf16_t* vg = ((bf16_t*)(p.ws + OFF_ZT)) + (size_t)(TVB + h * 128 + (tid >> 5)) * MT + b * SEQ + j * 256 + (tid & 31) * 8;
#pragma unroll
            for (int i = 0; i < 8; ++i) { rk[i] = *(const u32x4*)(kg + (size_t)(32 * i) * NZ); rv[i] = *(const u32x4*)(vg + (size_t)(16 * i) * MT); }
#pragma unroll
            for (int i = 0; i < 8; ++i) { *(LAS u32x4*)(Kb + ((tid >> 4) + 32 * i) * 136 + (tid & 15) * 8) = rk[i]; *(LAS u32x4*)(Vb + ((tid >> 5) + 16 * i) * 264 + (tid & 31) * 8) = rv[i]; }
            __syncthreads();
            cur_bhj = bhj;
        }
        const int cnt = (int)cntp[bhj];
        const bool own = (c == 0);
        int rowi[2]; bool valid[2]; unsigned smv[2];
#pragma unroll
        for (int cg = 0; cg < 2; ++cg) {
            const int idx = 32 * w + 16 * cg + fr;
            if (own) { rowi[cg] = j * 256 + idx; valid[cg] = true; }
            else { const int li = 256 * (c - 1) + idx; valid[cg] = li < cnt; rowi[cg] = valid[cg] ? (int)((const unsigned short*)(p.ws + OFF_list))[(size_t)bhj * 4096 + li] : j * 256; }
        }
        bf16x8 Q[2][4];
#pragma unroll
        for (int cg = 0; cg < 2; ++cg) { const bf16_t* qp = ((bf16_t*)(p.ws + OFF_Z)) + (size_t)(b * SEQ + rowi[cg]) * NZ + ZQB + h * 128 + 8 * g4;
            smv[cg] = ((const unsigned*)(p.ws + OFF_selm))[(size_t)bh * SEQ + rowi[cg]];
#pragma unroll
            for (int ks = 0; ks < 4; ++ks) Q[cg][ks] = *(const bf16x8*)(qp + 32 * ks); }
        f32x4 O[2][8];
#pragma unroll
        for (int cg = 0; cg < 2; ++cg)
#pragma unroll
            for (int dt = 0; dt < 8; ++dt) O[cg][dt] = (f32x4){0.f, 0.f, 0.f, 0.f};
        float mrun[2] = {-1.0e30f, -1.0e30f}, lrun[2] = {0.f, 0.f};
        const int ktn = own ? ((32 * w + 31) >> 6) + 1 : 4;
        if (own) moba_unit_body<true>(Kb, Vb, Q, rowi, j, ktn, fr, g4, O, mrun, lrun); else moba_unit_body<false>(Kb, Vb, Q, rowi, j, ktn, fr, g4, O, mrun, lrun);
#pragma unroll
        for (int cg = 0; cg < 2; ++cg) {
            float lt = lrun[cg]; lt += __shfl_xor(lt, 16); lt += __shfl_xor(lt, 32);
            const float inv = 1.0f / lt;
            const int slot = own ? 3 : __popc(smv[cg] & ((1u << j) - 1u));
            if (valid[cg]) {
                bf16_t* op = ((bf16_t*)(p.ws + OFF_opart)) + (((size_t)bh * SEQ + rowi[cg]) * 4 + slot) * 128 + 4 * g4;
#pragma unroll
                for (int dt = 0; dt < 8; ++dt) *(u32x2*)(op + 16 * dt) = pack4(O[cg][dt] * inv);
                if (g4 == 0) { float* mlp = ((float*)(p.ws + OFF_ml)) + (((size_t)bh * SEQ + rowi[cg]) * 4 + slot) * 2; mlp[0] = mrun[cg]; mlp[1] = lt; }
            }
        }
    }
    __syncthreads();
}
__device__ __forceinline__ void moba_combine(const Params& p, int tid) {
    const int lane = tid & 63, w = tid >> 6, sub = lane >> 4, dl = lane & 15;
    const int stride = gridDim.x * 32;
    for (int pr0 = (blockIdx.x * 8 + w) * 4 + sub; pr0 < MT * 8; pr0 += 2 * stride) {
        int tok[2], hh[2]; size_t rb[2]; unsigned sm[2];
#pragma unroll
        for (int k = 0; k < 2; ++k) { const int pr = pr0 + k * stride < MT * 8 ? pr0 + k * stride : pr0; tok[k] = pr >> 3; hh[k] = pr & 7; rb[k] = (size_t)((tok[k] >> 12) * 8 + hh[k]) * SEQ + (tok[k] & (SEQ - 1)); }
#pragma unroll
        for (int k = 0; k < 2; ++k) sm[k] = ((const unsigned*)(p.ws + OFF_selm))[rb[k]];
        f32x4 ml0[2], ml1[2]; u32x4 ov[2][4];
#pragma unroll
        for (int k = 0; k < 2; ++k) { const f32x4* mlp = (const f32x4*)(((const float*)(p.ws + OFF_ml)) + rb[k] * 8); ml0[k] = mlp[0]; ml1[k] = mlp[1];
            const bf16_t* op = ((const bf16_t*)(p.ws + OFF_opart)) + rb[k] * 512 + 8 * dl;
#pragma unroll
            for (int sl = 0; sl < 4; ++sl) ov[k][sl] = *(const u32x4*)(op + sl * 128); }
#pragma unroll
        for (int k = 0; k < 2; ++k) {
            const int nsel = __popc(sm[k]);
            const float mraw[4] = {ml0[k][0], ml0[k][2], ml1[k][0], ml1[k][2]}, lraw[4] = {ml0[k][1], ml0[k][3], ml1[k][1], ml1[k][3]};
            float mm[4]; bool on[4];
#pragma unroll
            for (int sl = 0; sl < 4; ++sl) { on[sl] = (sl == 3) || (sl < nsel); mm[sl] = on[sl] ? mraw[sl] : -1.0e30f; }
            const float M = fmaxf(fmaxf(mm[0], mm[1]), fmaxf(mm[2], mm[3]));
            float wsum = 0.f; f32x4 a0 = {0.f, 0.f, 0.f, 0.f}, a1 = a0;
#pragma unroll
            for (int sl = 0; sl < 4; ++sl) {
                const float wgt = on[sl] ? lraw[sl] * ex2(mm[sl] - M) : 0.f; wsum += wgt; const u32x4 v = ov[k][sl];
                const f32x4 x0 = {bflo(v.x), bfhi(v.x), bflo(v.y), bfhi(v.y)}, x1 = {bflo(v.z), bfhi(v.z), bflo(v.w), bfhi(v.w)};
#pragma unroll
                for (int e = 0; e < 4; ++e) { a0[e] += on[sl] ? x0[e] * wgt : 0.f; a1[e] += on[sl] ? x1[e] * wgt : 0.f; }
            }
            const float inv = 1.0f / wsum;
            if (k == 0 || pr0 + stride < MT * 8) *(bf16x8*)(((bf16_t*)(p.ws + OFF_yA)) + (size_t)tok[k] * 2048 + 512 + hh[k] * 128 + 8 * dl) = pack8(a0 * inv, a1 * inv);
        }
    }
}

__device__ __forceinline__ void gmlp_unit(const Params& p, LAS unsigned char* lds, int unit, int tid, int layer) {
    const int grp = unit & 3, cc = (unit >> 2) & 31, b = unit >> 7;
    const int tok0 = b * SEQ + cc * 128;
    LAS float* red = (LAS float*)lds; LAS float* sMean = red + 1024; LAS float* sRstd = sMean + 128;
    LAS bf16_t* vn = (LAS bf16_t*)(lds + 8192);
    {
        const int chunk = tid & 15, chg = tid >> 4;
        const bf16_t* src = ((bf16_t*)(p.ws + OFF_ZT)) + (size_t)(TVC + chg) * MT + tok0 + chunk * 8;
        u32x4 v[16];
#pragma unroll
        for (int i = 0; i < 16; ++i) v[i] = *(const u32x4*)(src + (size_t)(32 * i) * MT);
        float s8[8], q8[8];
#pragma unroll
        for (int e = 0; e < 8; ++e) { s8[e] = 0.f; q8[e] = 0.f; }
#pragma unroll
        for (int i = 0; i < 16; ++i) {
            const float x[8] = {bflo(v[i].x), bfhi(v[i].x), bflo(v[i].y), bfhi(v[i].y), bflo(v[i].z), bfhi(v[i].z), bflo(v[i].w), bfhi(v[i].w)};
#pragma unroll
            for (int e = 0; e < 8; ++e) { s8[e] += x[e]; q8[e] += x[e] * x[e]; }
        }
        LAS float* red2 = (LAS float*)(lds + 49152);
#pragma unroll
        for (int e = 0; e < 8; ++e) { red2[(chg * 128 + chunk * 8 + e) * 2] = s8[e]; red2[(chg * 128 + chunk * 8 + e) * 2 + 1] = q8[e]; }
    }
    __syncthreads();
    if (tid < 128) { float s = 0.f, q = 0.f; const LAS float* red2 = (const LAS float*)(lds + 49152);
#pragma unroll 8
        for (int g = 0; g < 32; ++g) { s += red2[(g * 128 + tid) * 2]; q += red2[(g * 128 + tid) * 2 + 1]; }
        const float mean = s * (1.0f / 512.0f); const float var = fmaxf(q * (1.0f / 512.0f) - mean * mean, 0.f);
        sMean[tid] = mean; sRstd[tid] = rsqrtf(var + 1e-6f); }
    __syncthreads();
    { const int e = tid >> 2, sc = (tid & 3) * 32; const int ch = grp * 128 + e;
      const float gg = p.in[6][layer * 512 + ch], bb = p.in[7][layer * 512 + ch];
      const bf16_t* src = ((bf16_t*)(p.ws + OFF_ZT)) + (size_t)(TVC + ch) * MT + tok0 + sc;
#pragma unroll
      for (int i = 0; i < 4; ++i) { const u32x4 v = *(const u32x4*)(src + 8 * i); const int s0 = sc + 8 * i;
          const f32x4 x0 = {bflo(v.x), bfhi(v.x), bflo(v.y), bfhi(v.y)}, x1 = {bflo(v.z), bfhi(v.z), bflo(v.w), bfhi(v.w)};
          f32x4 y0, y1;
#pragma unroll
          for (int j = 0; j < 4; ++j) { y0[j] = (x0[j] - sMean[s0 + j]) * sRstd[s0 + j] * gg + bb; y1[j] = (x1[j] - sMean[s0 + 4 + j]) * sRstd[s0 + 4 + j] * gg + bb; }
          *(LAS bf16x8*)(vn + e * 136 + s0) = pack8(y0, y1); } }
    __syncthreads();
    const int lane = tid & 63, w = tid >> 6, fr = lane & 15, g4 = lane >> 4;
    const int t = 16 * w + fr;
    f32x4 acc[8];
#pragma unroll
    for (int et = 0; et < 8; ++et) acc[et] = (f32x4){0.f, 0.f, 0.f, 0.f};
    const float* wrow = p.in[8] + (((size_t)layer * 4 + grp) * 128 + t) * 128;
    const int ksmax = (16 * w + 15) >> 5;
#pragma unroll
    for (int ks = 0; ks < 4; ++ks) if (ks <= ksmax) {
        const int s0 = 32 * ks + 8 * g4;
        f32x4 w0 = *(const f32x4*)(wrow + s0), w1 = *(const f32x4*)(wrow + s0 + 4);
#pragma unroll
        for (int j = 0; j < 4; ++j) { if (s0 + j > t) w0[j] = 0.f; if (s0 + 4 + j > t) w1[j] = 0.f; }
        const bf16x8 B = pack8(w0, w1);
#pragma unroll
        for (int et = 0; et < 8; ++et) acc[et] = mfma16(*(const LAS bf16x8*)(vn + (16 * et + fr) * 136 + s0), B, acc[et]);
    }
    const float bs = p.in[9][((size_t)layer * 4 + grp) * 128 + t];
#pragma unroll
    for (int et = 0; et < 8; ++et) {
        const int e0 = 16 * et + 4 * g4;
        const f32x4 uu = unpack4(*(const u32x2*)(((bf16_t*)(p.ws + OFF_Z)) + (size_t)(tok0 + t) * NZ + ZUC + grp * 128 + e0));
        f32x4 y;
#pragma unroll
        for (int j = 0; j < 4; ++j) y[j] = uu[j] * (acc[et][j] + bs);
        *(u32x2*)(((bf16_t*)(p.ws + OFF_yA)) + (size_t)(tok0 + t) * 2048 + 1536 + grp * 128 + e0) = pack4(y);
    }
    __syncthreads();
}

__device__ __forceinline__ void final_norm(const Params& p, const float* ssq, int tid) {
    const int lane = tid & 63, w = tid >> 6;
    for (int row = blockIdx.x * 8 + w; row < MT; row += gridDim.x * 8) {
        float s = lane < 32 ? ssq[(size_t)row * 32 + lane] : 0.f;
        s = wave_sum(s);
        const float rs = rsqrtf(s * (1.0f / 2048.0f) + 1e-6f);
#pragma unroll
        for (int i = 0; i < 8; ++i) { const int k = 4 * lane + 256 * i; const f32x4 v = *(const f32x4*)(((float*)(p.ws + OFF_xres)) + (size_t)row * DM + k); const f32x4 g = *(const f32x4*)(p.in[20] + k); *(f32x4*)(p.out + (size_t)row * DM + k) = v * rs * g; }
    }
}

__global__ void __launch_bounds__(512, 2) mega(Params p) {
    extern __shared__ __attribute__((aligned(16))) unsigned char smem_[];
    LAS unsigned char* lds = (LAS unsigned char*)smem_;
    cg::grid_group grid = cg::this_grid();
    const int tid0 = threadIdx.x, G = gridDim.x, bid = blockIdx.x;
    const int lid = (G & 7) ? bid : (bid & 7) * (G >> 3) + (bid >> 3);
#define tid opq(tid0)
    int ph = 0;
    volatile LAS unsigned* xst = (volatile LAS unsigned*)(lds + XST_OFF);
    if (tid0 == 0) { xst[0] = 0u; xst[1] = 0u; xst[2] = 0u; xst[3] = 0u; }
    __syncthreads();
    const XcdBarrier xb = xcd_barrier_post((unsigned*)(p.ws + OFF_bar), xst);
#define PH_ON (ph >= p.ph_lo && ph < p.ph_hi)
#define PH_END do { if (PH_ON && ph + 1 < p.ph_hi) xcd_barrier(xb); ++ph; } while (0)
    if (p.ph_hi < 0) grid.sync();
    for (int rep_ = 0; rep_ < (PH_ON && PHM(0) ? 1 + REPM(0) : 0); ++rep_, (rep_ <= REPM(0) ? grid.sync() : (void)0)) prologue(p, lds, tid);
    PH_END;
#ifdef EXTRA_SYNCS
    for (int i_ = 0; i_ < EXTRA_SYNCS; ++i_) grid.sync();
#endif
    for (int l = 0; l < 2; ++l) {
        const int cur = l & 1;
        bf16_t* xbc = cur ? ((bf16_t*)(p.ws + OFF_xb1)) : ((bf16_t*)(p.ws + OFF_xb0)); bf16_t* xbn = cur ? ((bf16_t*)(p.ws + OFF_xb0)) : ((bf16_t*)(p.ws + OFF_xb1));
        float* ssc = cur ? ((float*)(p.ws + OFF_ssq1)) : ((float*)(p.ws + OFF_ssq0)); float* ssn = cur ? ((float*)(p.ws + OFF_ssq0)) : ((float*)(p.ws + OFF_ssq1));
        const bf16_t* wti = ((bf16_t*)(p.ws + OFF_wt_in)) + (size_t)l * NWIN * 2048;
        for (int rep_ = 0; rep_ < (PH_ON && PHM(1) ? 1 + REPM(1) : 0); ++rep_, (rep_ <= REPM(1) ? grid.sync() : (void)0)) {
            gates_phase(p, l, l == 0 ? p.in[0] : ((float*)(p.ws + OFF_xres)), tid);
            { EpiZ E{((bf16_t*)(p.ws + OFF_Z)), ssc, ((float*)(p.ws + OFF_rope))}; run_gemm(lds, xbc, wti, MT, NZ, DM, E); }
            { EpiZT E{((bf16_t*)(p.ws + OFF_ZT)), ssc}; run_gemm(lds, wti + (size_t)NZ * 2048, xbc, NTR, MT, DM, E); }
        }
        PH_END;
        for (int rep_ = 0; rep_ < (PH_ON && PHM(2) ? 1 + REPM(2) : 0); ++rep_, (rep_ <= REPM(2) ? grid.sync() : (void)0)) {
            for (int u = bid; u < 512; u += G) mlstm_a_unit(p, lds, u, tid);
            for (int u = lid; u < 256; u += G) kmean_unit(p, lds, u, tid);
            if (bid == 0 && tid < 256) ((unsigned*)(p.ws + OFF_cnt))[tid] = 0u;
            for (int u = lid; u < 256; u += G) gmlp_unit(p, lds, u, tid, l);
        }
        PH_END;
        for (int rep_ = 0; rep_ < (PH_ON && PHM(3) ? 1 + REPM(3) : 0); ++rep_, (rep_ <= REPM(3) ? grid.sync() : (void)0)) {
            mlstm_scan(p, tid);
            for (int u = lid; u < 512; u += G) moba_gate_unit(p, lds, u, tid);
        }
        PH_END;
        for (int rep_ = 0; rep_ < (PH_ON && PHM(4) ? 1 + REPM(4) : 0); ++rep_, (rep_ <= REPM(4) ? grid.sync() : (void)0)) { moba_attn_phase(p, lds, tid); for (int u = bid; u < 512; u += G) mlstm_c_unit(p, lds, u, tid, l); }
        PH_END;
        for (int rep_ = 0; rep_ < (PH_ON && PHM(11) ? 1 + REPM(11) : 0); ++rep_, (rep_ <= REPM(11) ? grid.sync() : (void)0)) { moba_combine(p, tid); }
        PH_END;
        for (int rep_ = 0; rep_ < (PH_ON && PHM(5) ? 1 + REPM(5) : 0); ++rep_, (rep_ <= REPM(5) ? grid.sync() : (void)0)) {
            { EpiMerge E{((bf16_t*)(p.ws + OFF_Z)), ((bf16_t*)(p.ws + OFF_mergedb))}; run_gemm<EpiMerge, MergeOrder>(lds, ((bf16_t*)(p.ws + OFF_yA)), ((bf16_t*)(p.ws + OFF_wt_a)) + (size_t)l * 2048 * 2048, MT, DM, DM, E); }
        }
        PH_END;
        for (int rep_ = 0; rep_ < (PH_ON && PHM(6) ? 1 + REPM(6) : 0); ++rep_, (rep_ <= REPM(6) ? grid.sync() : (void)0)) { EpiRes<0> E{l == 0 ? p.in[0] : ((float*)(p.ws + OFF_xres)), ((float*)(p.ws + OFF_xres)), xbn, ssn, nullptr, nullptr}; run_gemm(lds, ((bf16_t*)(p.ws + OFF_mergedb)), ((bf16_t*)(p.ws + OFF_wt_out)) + (size_t)l * 2048 * 2048, MT, DM, DM, E); }
        PH_END;
        for (int rep_ = 0; rep_ < (PH_ON && PHM(7) ? 1 + REPM(7) : 0); ++rep_, (rep_ <= REPM(7) ? grid.sync() : (void)0)) {
            { EpiUp E{((bf16_t*)(p.ws + OFF_hidden)), ssn}; run_gemm(lds, xbn, ((bf16_t*)(p.ws + OFF_wt_up)) + (size_t)l * 8192 * 2048, MT, FF, DM, E); }
            { EpiP E{((bf16_t*)(p.ws + OFF_pple)), DM}; run_gemm(lds, ((bf16_t*)(p.ws + OFF_pb)) + (size_t)l * MT * 256, ((bf16_t*)(p.ws + OFF_wt_pe)) + (size_t)l * 2048 * 256, MT, DM, 256, E); }
        }
        PH_END;
        for (int rep_ = 0; rep_ < (PH_ON && PHM(8) ? 1 + REPM(8) : 0); ++rep_, (rep_ <= REPM(8) ? grid.sync() : (void)0)) { EpiRes<0> E{((float*)(p.ws + OFF_xres)), ((float*)(p.ws + OFF_xres)), xbc, ssc, nullptr, nullptr}; run_gemm(lds, ((bf16_t*)(p.ws + OFF_hidden)), ((bf16_t*)(p.ws + OFF_wt_down)) + (size_t)l * 2048 * 8192, MT, DM, FF, E); }
        PH_END;
        for (int rep_ = 0; rep_ < (PH_ON && PHM(9) ? 1 + REPM(9) : 0); ++rep_, (rep_ <= REPM(9) ? grid.sync() : (void)0)) { EpiRes<1> E{((float*)(p.ws + OFF_xres)), ((float*)(p.ws + OFF_xres)), l == 1 ? nullptr : xbn, ssn, ssc, ((bf16_t*)(p.ws + OFF_pple))}; run_gemm(lds, xbc, ((bf16_t*)(p.ws + OFF_wt_pg)) + (size_t)l * 2048 * 2048, MT, DM, DM, E); }
        PH_END;
    }
    for (int rep_ = 0; rep_ < (PH_ON && PHM(10) ? 1 + REPM(10) : 0); ++rep_, (rep_ <= REPM(10) ? grid.sync() : (void)0)) final_norm(p, ((float*)(p.ws + OFF_ssq0)), tid);
#undef PH_ON
#undef PH_END
#undef tid
}

__global__ void fill_diag(float* o, int n, float v) { for (int i = blockIdx.x * blockDim.x + threadIdx.x; i < n; i += gridDim.x * blockDim.x) o[i] = v; }
extern "C" void kernel_launch(void* const* d_in, const int* in_sizes, int n_in, void* d_out, int out_size, void* d_ws, size_t ws_size, hipStream_t stream) {
    static int grid_blocks = 0;
    if (!grid_blocks) {
        int dev = 0, cus = 0, per_cu = 0;
        hipGetDevice(&dev);
        hipDeviceGetAttribute(&cus, hipDeviceAttributeMultiprocessorCount, dev);
        hipFuncSetAttribute((const void*)mega, hipFuncAttributeMaxDynamicSharedMemorySize, LDS_BYTES);
        hipOccupancyMaxActiveBlocksPerMultiprocessor(&per_cu, (const void*)mega, 512, LDS_BYTES);
        if (per_cu < 1) { fprintf(stderr, "kernel_launch: occupancy query says %d blocks per CU\n", per_cu); per_cu = 1; }
        grid_blocks = cus * 1;
        (void)hipGetLastError();
    }
    Params p{};
    for (int i = 0; i < 21; ++i) p.in[i] = (const float*)d_in[i];
    p.out = (float*)d_out; p.ws = (unsigned char*)d_ws;
    if (n_in != 21 || OFF_END > ws_size) { fill_diag<<<1024, 256, 0, stream>>>((float*)d_out, out_size, n_in != 21 ? 50000.f + n_in : (float)(ws_size >> 20)); return; }
    (void)hipMemsetAsync((unsigned char*)d_ws + OFF_bar, 0, (size_t)XCD_BAR_WORDS * 4, stream);
#if N_LAUNCH_MODE == 0
    p.ph_lo = 0; p.ph_hi = PHASE_LIMIT;
    void* args[] = {&p};
    hipError_t e = hipLaunchCooperativeKernel((const void*)mega, dim3(grid_blocks), dim3(512), args, LDS_BYTES, stream);
    if (e != hipSuccess) fprintf(stderr, "kernel_launch: cooperative launch failed: %s (grid %d)\n", hipGetErrorString(e), grid_blocks);
#else
    for (int ph = 0; ph < PHASE_LIMIT; ++ph) { p.ph_lo = ph; p.ph_hi = ph + 1; hipLaunchKernelGGL(mega, dim3(grid_blocks), dim3(512), LDS_BYTES, stream, p); }
#endif
}
```

```cpp
#include <hip/hip_runtime.h>
#include <hip/hip_cooperative_groups.h>
#include <cstdio>
namespace cg = cooperative_groups;
namespace pg8 {
#define PG8_LAS __attribute__((address_space(3)))
typedef unsigned short bf16_t;
typedef short bf16x8 __attribute__((ext_vector_type(8)));
typedef float f32x4 __attribute__((ext_vector_type(4)));
typedef unsigned u32x4 __attribute__((ext_vector_type(4)));
constexpr int BM = 256, BK = 64, HALF = 128, HTB = HALF * BK * 2  , STAGE_BYTES = 8 * HTB, NXCD = 8, WGM = 8;

__host__ __device__ __forceinline__ int lds_byte(int r, int c) { const int st = (r >> 4) * 2 + (c >> 5), rr = r & 15, cc = c & 31, ob = rr * 64 + cc * 2; return st * 1024 + (ob ^ (((ob >> 9) & 1) << 5)); }
__host__ __device__ __forceinline__ void stage_rc(int b, int& R, int& C) { const int st = b / 1024, sb = b % 1024, swz = sb ^ (((sb >> 9) & 1) << 5); R = (st >> 1) * 16 + swz / 64; C = (st & 1) * 32 + (swz % 64) / 2; }
__host__ __device__ __forceinline__ int perm32(int rho) { const int n = rho >> 4, i = rho & 15; return 8 * (i >> 2) + 4 * n + (i & 3); }

struct Unit { int pm, pn, kt0, nkt, zero; };
struct Gemm { const bf16_t* A; const bf16_t* Bt; int M, N, K; };

struct StaticOrder {
    int nM, nN, nwg, G, c, nkt;
    __host__ __device__ void init(int M, int N, int G_, int c_, int K_) { nM = M / BM; nN = N / BM; nwg = nM * nN; G = G_; c = c_; nkt = K_ / BK; }
    __host__ __device__ bool next(int i, Unit& u) const {
        const long L = (long)i * G + c; if (L >= nwg) return false;
        int wgid = (int)L; { const int q = nwg / NXCD, r = nwg % NXCD, xcd = wgid % NXCD, off = wgid / NXCD; wgid = (xcd < r ? xcd * (q + 1) : r * (q + 1) + (xcd - r) * q) + off; }
        const int nig = WGM * nN, gid = wgid / nig, fm = gid * WGM, gsz = (nM - fm) < WGM ? (nM - fm) : WGM;
        u.pm = fm + ((wgid % nig) % gsz); u.pn = (wgid % nig) / gsz; u.kt0 = 0; u.nkt = nkt; u.zero = 1; return true;
    }
    __device__ __forceinline__ void a_ready(const Unit&) const {}
    __device__ __forceinline__ void done(const Unit&) const {}
};
__device__ __forceinline__ unsigned cvt_pk_bf16(float lo, float hi) { unsigned r; asm volatile("v_cvt_pk_bf16_f32 %0, %1, %2" : "=v"(r) : "v"(lo), "v"(hi)); return r; }
typedef float f32x2 __attribute__((ext_vector_type(2)));
template <class Epi, class Sched, bool STAMP = false>
__device__ __forceinline__ void gemm_phase(PG8_LAS unsigned char* lds, const Gemm g, const Sched& S, const Epi& E, unsigned long long* stamps) {
    int tid_ = threadIdx.x; asm volatile("" : "+v"(tid_)); const int tid = tid_, wid = __builtin_amdgcn_readfirstlane(tid >> 6), lane = tid & 63, wr = wid >> 2, wc = wid & 3, fr = lane & 15, fq = lane >> 4;
    const int K = g.K;
    int ts_lo = 0, ts_hi = 0, nts = 0; const unsigned long long rt_entry = STAMP ? (unsigned long long)wall_clock64() : 0ull;
#define PG8_STAMP() do { if (STAMP && wid == 0 && nts < 64) { const unsigned long long _c = (unsigned long long)clock64(); \
        ts_lo = (lane == nts) ? (int)(unsigned)_c : ts_lo; ts_hi = (lane == nts) ? (int)(unsigned)(_c >> 32) : ts_hi; ++nts; } } while (0)
    PG8_STAMP();
    unsigned voffA[2], voffB[2];
#pragma unroll
    for (int i = 0; i < 2; ++i) { int R, C; stage_rc(tid * 16 + i * 8192, R, C); const int Rb = Epi::PERM ? ((R & ~31) + perm32(R & 31)) : R;
        voffA[i] = (unsigned)(R * K + C) * 2u; voffB[i] = (unsigned)(Rb * K + C) * 2u; }
    const size_t kstep = (size_t)(BK * 2);
    const size_t hstep = (size_t)HALF * K * 2;
    const size_t tstep = 2 * hstep;
    const unsigned ldsw = (unsigned)wid * 1024u;
    const int aoff = lds_byte(wr * 64 + fr, fq * 8), boff = lds_byte(wc * 32 + fr, fq * 8);
#define PG8_SA(b, h) (((b) * 2 + (h)) * HTB)
#define PG8_SB(b, h) ((4 + (b) * 2 + (h)) * HTB)
#define PG8_STAGE(bufoff, gbase, voff) do { _Pragma("unroll") for (int _i = 0; _i < 2; ++_i) \
        __builtin_amdgcn_global_load_lds((const unsigned*)((const char*)(gbase) + (voff)[_i]), (PG8_LAS unsigned*)(lds + (bufoff) + ldsw + _i * 8192), 16, 0, 0); } while (0)
#define PG8_LDA(dst, b, h) do { _Pragma("unroll") for (int m = 0; m < 4; ++m) _Pragma("unroll") for (int k = 0; k < 2; ++k) dst[m][k] = *(const PG8_LAS bf16x8*)(lds + PG8_SA(b, h) + aoff + m * 2048 + k * 1024); } while (0)
#define PG8_LDB(dst, b, h) do { _Pragma("unroll") for (int n = 0; n < 2; ++n) _Pragma("unroll") for (int k = 0; k < 2; ++k) dst[n][k] = *(const PG8_LAS bf16x8*)(lds + PG8_SB(b, h) + boff + n * 2048 + k * 1024); } while (0)
#define PG8_MMA(ai, bj, At, Bt) do { __builtin_amdgcn_s_setprio(1); _Pragma("unroll") for (int m = 0; m < 4; ++m) _Pragma("unroll") for (int n = 0; n < 2; ++n) _Pragma("unroll") for (int k = 0; k < 2; ++k) \
        acc[ai][bj][m][n] = __builtin_amdgcn_mfma_f32_16x16x32_bf16(Bt[n][k], At[m][k], acc[ai][bj][m][n], 0, 0, 0); __builtin_amdgcn_s_setprio(0); } while (0)
#define PG8_WAIT_V(n) asm volatile("s_waitcnt vmcnt(" #n ")" ::: "memory")
#define PG8_WAIT_L(n) asm volatile("s_waitcnt lgkmcnt(" #n ")" ::: "memory")
#define PG8_BAR __builtin_amdgcn_s_barrier()
#define PG8_SCHED __builtin_amdgcn_sched_barrier(0)
    Unit cur, nxt; int ui = 0;
    if (!S.next(0, cur)) return;
    f32x4 acc[2][2][4][2];
#pragma unroll
    for (int a = 0; a < 2; ++a)
#pragma unroll
        for (int b = 0; b < 2; ++b)
#pragma unroll
            for (int m = 0; m < 4; ++m)
#pragma unroll
                for (int n = 0; n < 2; ++n) acc[a][b][m][n] = (f32x4){0.f, 0.f, 0.f, 0.f};
    bf16x8 At[4][2], B0[2][2], B1[2][2];
    const char* cA = (const char*)g.A + (size_t)cur.pm * tstep + (size_t)cur.kt0 * kstep; const char* cB = (const char*)g.Bt + (size_t)cur.pn * tstep + (size_t)cur.kt0 * kstep;
    S.a_ready(cur);
    PG8_STAGE(PG8_SB(0, 0), cB, voffB); PG8_STAGE(PG8_SB(0, 1), cB + hstep, voffB); PG8_STAGE(PG8_SA(0, 0), cA, voffA); PG8_STAGE(PG8_SA(0, 1), cA + hstep, voffA);
    if (wr == 1) PG8_BAR;
    PG8_WAIT_V(2); PG8_BAR;
    PG8_STAGE(PG8_SB(1, 0), cB + kstep, voffB); PG8_STAGE(PG8_SA(1, 0), cA + kstep, voffA); PG8_STAGE(PG8_SB(1, 1), cB + hstep + kstep, voffB);
    PG8_WAIT_V(6); PG8_BAR;
    PG8_STAMP();
    for (;;) {
        const bool has_next = S.next(ui + 1, nxt);
        const char* nA = has_next ? (const char*)g.A + (size_t)nxt.pm * tstep + (size_t)nxt.kt0 * kstep : cA; const char* nB = has_next ? (const char*)g.Bt + (size_t)nxt.pn * tstep + (size_t)nxt.kt0 * kstep : cB;
        const int nt = cur.nkt;
        for (int t = 0; t < nt; t += 2) {
            const bool last = (t == nt - 2);
            const char* a1 = cA + (size_t)(t + 1) * kstep;
            const char* a2 = last ? nA : cA + (size_t)(t + 2) * kstep; const char* b2 = last ? nB : cB + (size_t)(t + 2) * kstep;
            const char* a3 = a2 + kstep; const char* b3 = b2 + kstep;
            if (last && has_next) S.a_ready(nxt);
            PG8_LDB(B0, 0, 0); PG8_LDB(B1, 0, 1); PG8_SCHED; PG8_LDA(At, 0, 0); PG8_STAGE(PG8_SA(1, 1), a1 + hstep, voffA);
            PG8_WAIT_V(8); PG8_WAIT_L(0); PG8_BAR; PG8_MMA(0, 0, At, B0); PG8_MMA(0, 1, At, B1); PG8_BAR; PG8_SCHED;
            PG8_LDA(At, 0, 1); PG8_STAGE(PG8_SB(0, 0), b2, voffB); PG8_STAGE(PG8_SB(0, 1), b2 + hstep, voffB); PG8_STAGE(PG8_SA(0, 0), a2, voffA);
            PG8_WAIT_V(8); PG8_WAIT_L(0); PG8_BAR; PG8_MMA(1, 0, At, B0); PG8_MMA(1, 1, At, B1); PG8_BAR; PG8_SCHED;
            PG8_LDB(B0, 1, 0); PG8_LDB(B1, 1, 1); PG8_SCHED; PG8_LDA(At, 1, 0); PG8_STAGE(PG8_SA(0, 1), a2 + hstep, voffA);
            PG8_WAIT_V(8); PG8_WAIT_L(0); PG8_BAR; PG8_MMA(0, 0, At, B0); PG8_MMA(0, 1, At, B1); PG8_BAR; PG8_SCHED;
            PG8_LDA(At, 1, 1); PG8_STAGE(PG8_SB(1, 0), b3, voffB); PG8_STAGE(PG8_SB(1, 1), b3 + hstep, voffB); PG8_STAGE(PG8_SA(1, 0), a3, voffA);
            PG8_WAIT_V(8); PG8_WAIT_L(0); PG8_BAR; PG8_MMA(1, 0, At, B0); PG8_MMA(1, 1, At, B1); PG8_BAR; PG8_SCHED;
        }
        PG8_STAMP();
        if (wr == 0) PG8_BAR;
        if constexpr (Epi::HAS_MID) { E.mid(acc, cur, wr, wc, fr, fq); } else if constexpr (!Epi::AFTER_DRAIN) { E(acc, cur, wr, wc, fr, fq); S.done(cur); }
        PG8_STAMP();
        if (!has_next) break;
        if (cur.zero)
#pragma unroll
        for (int a = 0; a < 2; ++a)
#pragma unroll
            for (int b = 0; b < 2; ++b)
#pragma unroll
                for (int m = 0; m < 4; ++m)
#pragma unroll
                    for (int n = 0; n < 2; ++n) acc[a][b][m][n] = (f32x4){0.f, 0.f, 0.f, 0.f};
        cur = nxt; cA = nA; cB = nB; ++ui;
        if (wr == 1) PG8_BAR;
    }
    PG8_WAIT_V(0);
    PG8_BAR;
    if constexpr (Epi::AFTER_DRAIN) { E.fused(acc, cur, wr, wc, fr, fq, lds, wid, lane); S.done(cur); }
    PG8_STAMP();
    if (STAMP && wid == 0) { stamps[lane] = lane < nts ? (((unsigned long long)(unsigned)ts_hi << 32) | (unsigned)ts_lo) : 0ull;
        if (lane == 62) stamps[62] = rt_entry; if (lane == 63) stamps[63] = (unsigned long long)wall_clock64(); }
#undef PG8_STAMP
#undef PG8_SA
#undef PG8_SB
#undef PG8_STAGE
#undef PG8_LDA
#undef PG8_LDB
#undef PG8_MMA
#undef PG8_WAIT_V
#undef PG8_WAIT_L
#undef PG8_BAR
#undef PG8_SCHED
}
}

using pg8::bf16_t; using pg8::bf16x8; using pg8::f32x4; using pg8::u32x4; using pg8::cvt_pk_bf16; using pg8::Unit;
#define LAS __attribute__((address_space(3)))
typedef unsigned u32x2 __attribute__((ext_vector_type(2)));
#define XB_TMO      128
#define XB_XCNT(j)  (256  + 64 * (j))
#define XB_XSUB(j)  (1280 + 64 * (j))
#define XB_XGEN(j)  (2304 + 64 * (j))
#define XB_TOP      3328
#define XB_TOPGEN   3392
#define XCD_BAR_WORDS 3456
#define XB_SPIN_CAP (1u << 18)

__device__ __forceinline__ unsigned xb_ld(unsigned* p)              { return __hip_atomic_load(p, __ATOMIC_RELAXED, __HIP_MEMORY_SCOPE_AGENT); }
__device__ __forceinline__ unsigned xb_add(unsigned* p, unsigned v) { return __hip_atomic_fetch_add(p, v, __ATOMIC_RELAXED, __HIP_MEMORY_SCOPE_AGENT); }
__device__ __forceinline__ unsigned xb_xcc_id() { return (unsigned)__builtin_amdgcn_s_getreg((3 << 11) | 20) & 0xFu; }
#define XB_SPIN(cond, bar) do { unsigned _sp = 0; while (cond) { __builtin_amdgcn_s_sleep(1); \
    if ((++_sp & 255u) == 0u) { if (xb_ld(&(bar)[XB_TMO])) break; if (_sp > XB_SPIN_CAP) { atomicAdd(&(bar)[XB_TMO], 1u); break; } } } } while (0)

struct XcdBarrier {
    unsigned* bar; unsigned x;
    volatile LAS unsigned* st;
};

__device__ __forceinline__ XcdBarrier xcd_barrier_post(unsigned* bar, volatile LAS unsigned* st) {
    XcdBarrier b; b.bar = bar; b.x = xb_xcc_id(); b.st = st;
    if (threadIdx.x == 0) (void)xb_add(&bar[XB_XCNT(b.x)], 1u);
    return b;
}
__device__ __forceinline__ void xcd_barrier_complete(unsigned* bar, unsigned x, unsigned& nloc, unsigned& nx) {
    const unsigned G = gridDim.x * gridDim.y * gridDim.z;
    unsigned sum, cnt, mine, sp = 0u;
    for (;;) {
        sum = 0u; cnt = 0u; mine = 0u;
#pragma unroll
        for (unsigned j = 0; j < 16; ++j) { const unsigned c = xb_ld(&bar[XB_XCNT(j)]); sum += c; cnt += (c > 0u) ? 1u : 0u; mine = (j == x) ? c : mine; }
        if (sum == G) break;
        __builtin_amdgcn_s_sleep(1);
        if ((++sp & 255u) == 0u) { if (xb_ld(&bar[XB_TMO])) break; if (sp > XB_SPIN_CAP) { atomicAdd(&bar[XB_TMO], 1u); break; } }
    }
    nloc = mine > 0u ? mine : 1u; nx = cnt > 0u ? cnt : 1u;
}

__device__ __forceinline__ void xcd_barrier(const XcdBarrier& b) {
    asm volatile("s_waitcnt vmcnt(0)" ::: "memory");
    __syncthreads();
    if (threadIdx.x == 0) {
        unsigned* bar = b.bar;
        __builtin_amdgcn_s_waitcnt(0);
        unsigned nloc = b.st[0], nx = b.st[1];
        if (nloc == 0u) { xcd_barrier_complete(bar, b.x, nloc, nx); b.st[0] = nloc; b.st[1] = nx; }
        const unsigned old = xb_add(&bar[XB_XSUB(b.x)], 1u);
        const unsigned gen = old / nloc;
        if (old + 1u == (gen + 1u) * nloc) {
            __builtin_amdgcn_fence(__ATOMIC_RELEASE, "agent");
            asm volatile("s_waitcnt vmcnt(0)" ::: "memory");
            const unsigned og = xb_add(&bar[XB_TOP], 1u);
            const unsigned tg = og / nx;
            if (og + 1u == (tg + 1u) * nx) xb_add(&bar[XB_TOPGEN], 1u);
            else XB_SPIN(xb_ld(&bar[XB_TOPGEN]) == tg, bar);
            __builtin_amdgcn_fence(__ATOMIC_ACQUIRE, "agent");
            xb_add(&bar[XB_XGEN(b.x)], 1u);
            asm volatile("s_waitcnt vmcnt(0)" ::: "memory");
        } else {
            XB_SPIN(xb_ld(&bar[XB_XGEN(b.x)]) == gen, bar);
            __builtin_amdgcn_fence(__ATOMIC_ACQUIRE, "agent");
            asm volatile("s_waitcnt vmcnt(0)" ::: "memory");
        }
    }
    __syncthreads();
}

typedef short bf16x4 __attribute__((ext_vector_type(4)));

#ifndef PHASE_LIMIT
#define PHASE_LIMIT N_PHASES
#endif
#ifndef REP_MASK
#define REP_MASK 0
#endif
#define REPM(k) (((REP_MASK) >> (k)) & 1)
#ifndef PHASE_MASK
#define PHASE_MASK 0xfff
#endif
#define PHM(k) (((PHASE_MASK) >> (k)) & 1)
#ifndef N_LAUNCH_MODE
#define N_LAUNCH_MODE 0
#endif

constexpr int MT = 8192, DM = 2048, SEQ = 4096, NZ = 10240, NTR = 2048, FF = 8192, NWIN = 12288, WIN_LD = 12296;
constexpr int ZQA = 0, ZKA = 512, ZOA = 1024, ZQB = 1536, ZKB = 2560, ZUC = 3584, ZG = 4096;
constexpr int TVA = 0, TVB = 512, TVC = 1536;
constexpr int XST_OFF = 139264;
constexpr int LDS_BYTES = XST_OFF + 256;
constexpr int N_PHASES = 1 + 10 * 2 + 1;

constexpr size_t al256(size_t x) { return (x + 255) & ~(size_t)255; }
constexpr size_t OFF_wt_in = 0;
constexpr size_t OFF_wt_a = OFF_wt_in + al256((size_t)2 * NWIN * 2048 * 2);
constexpr size_t OFF_wt_b = OFF_wt_a + al256((size_t)2 * 2048 * 512 * 2);
constexpr size_t OFF_wt_c = OFF_wt_b + al256((size_t)2 * 2048 * 1024 * 2);
constexpr size_t OFF_wt_out = OFF_wt_c + al256((size_t)2 * 2048 * 512 * 2);
constexpr size_t OFF_wt_up = OFF_wt_out + al256((size_t)2 * 2048 * 2048 * 2);
constexpr size_t OFF_wt_down = OFF_wt_up + al256((size_t)2 * 8192 * 2048 * 2);
constexpr size_t OFF_wt_pg = OFF_wt_down + al256((size_t)2 * 2048 * 8192 * 2);
constexpr size_t OFF_wt_pe = OFF_wt_pg + al256((size_t)2 * 2048 * 2048 * 2);
constexpr size_t OFF_gw = OFF_wt_pe + al256((size_t)2 * 2048 * 256 * 2);
constexpr size_t OFF_rope = OFF_gw + al256((size_t)2 * 2048 * 8 * 4);
constexpr size_t OFF_pb = OFF_rope + al256((size_t)SEQ * 16 * 2 * 4);
constexpr size_t OFF_xres = OFF_pb + al256((size_t)2 * MT * 256 * 2);
constexpr size_t OFF_xb0 = OFF_xres + al256((size_t)MT * DM * 4);
constexpr size_t OFF_xb1 = OFF_xb0 + al256((size_t)MT * DM * 2);
constexpr size_t OFF_ssq0 = OFF_xb1 + al256((size_t)MT * DM * 2);
constexpr size_t OFF_ssq1 = OFF_ssq0 + al256((size_t)MT * 32 * 4);
constexpr size_t OFF_Z = OFF_ssq1 + al256((size_t)MT * 32 * 4);
constexpr size_t OFF_ZT = OFF_Z + al256((size_t)MT * NZ * 2);
constexpr size_t OFF_GT = OFF_ZT + al256((size_t)NTR * MT * 2);
constexpr size_t OFF_dC = OFF_GT + al256((size_t)MT * 8 * 4);
constexpr size_t OFF_dn = OFF_dC + al256((size_t)8 * 64 * 16384 * 4);
constexpr size_t OFF_gsc = OFF_dn + al256((size_t)8 * 64 * 128 * 4);
constexpr size_t OFF_Cprev = OFF_gsc + al256((size_t)8 * 64 * 2 * 4);
constexpr size_t OFF_nprev = OFF_Cprev + al256((size_t)8 * 64 * 16384 * 2);
constexpr size_t OFF_mprev = OFF_nprev + al256((size_t)8 * 64 * 128 * 4);
constexpr size_t OFF_kmean = OFF_mprev + al256((size_t)8 * 64 * 4);
constexpr size_t OFF_yA = OFF_kmean + al256((size_t)16 * 16 * 128 * 4);
constexpr size_t OFF_yB = OFF_yA + al256((size_t)MT * 512 * 2);
constexpr size_t OFF_yC = OFF_yB + al256((size_t)MT * 1024 * 2);
constexpr size_t OFF_merged = OFF_xb0;
constexpr size_t OFF_mergedb = OFF_ZT;
constexpr size_t OFF_hidden = OFF_Z;
constexpr size_t OFF_pple = OFF_ZT;
constexpr size_t OFF_bar = OFF_yC + al256((size_t)MT * 512 * 2);
constexpr size_t OFF_selm = OFF_bar + al256((size_t)XCD_BAR_WORDS * 4);
constexpr size_t OFF_cnt = OFF_selm + al256((size_t)16 * 4096 * 4);
constexpr size_t OFF_list = OFF_cnt + al256((size_t)256 * 4);
constexpr size_t OFF_ml = OFF_list + al256((size_t)256 * 4096 * 2);
constexpr size_t OFF_opart = OFF_xb0;
constexpr size_t OFF_END = OFF_ml + al256((size_t)16 * 4096 * 4 * 2 * 4);
struct Params { const float* in[21]; float* out; unsigned char* ws; int ph_lo, ph_hi; };

__device__ __forceinline__ int opq(int v) { asm volatile("" : "+v"(v)); return v; }
__device__ __forceinline__ float bf2f(bf16_t b) { return __uint_as_float(((unsigned)b) << 16); }
__device__ __forceinline__ float bflo(unsigned w) { return __uint_as_float(w << 16); }
__device__ __forceinline__ float bfhi(unsigned w) { return __uint_as_float(w & 0xffff0000u); }
__device__ __forceinline__ bf16_t f2bf(float f) { return (bf16_t)(cvt_pk_bf16(f, 0.f) & 0xffffu); }
__device__ __forceinline__ float ex2(float x) { return __builtin_amdgcn_exp2f(x); }
__device__ __forceinline__ float sigm(float x) { return __builtin_amdgcn_rcpf(1.f + ex2(-1.4426950408889634f * x)); }
__device__ __forceinline__ float gelu_t(float x) { const float u = 0.7978845608028654f * (x + 0.044715f * x * x * x); return x * sigm(2.f * u); }
__device__ __forceinline__ float wave_sum(float v) {
#pragma unroll
    for (int o = 32; o >= 1; o >>= 1) v += __shfl_xor(v, o);
    return v; }
__device__ __forceinline__ float wave_max(float v) {
#pragma unroll
    for (int o = 32; o >= 1; o >>= 1) v = fmaxf(v, __shfl_xor(v, o));
    return v; }
__device__ __forceinline__ float wave_scan_add(float v, int lane) {
#pragma unroll
    for (int o = 1; o < 64; o <<= 1) { const float t = __shfl_up(v, o); if (lane >= o) v += t; }
    return v; }
__device__ __forceinline__ float wave_scan_max(float v, int lane) {
#pragma unroll
    for (int o = 1; o < 64; o <<= 1) { const float t = __shfl_up(v, o); if (lane >= o) v = fmaxf(v, t); }
    return v; }
__device__ __forceinline__ f32x4 mfma16(bf16x8 a, bf16x8 b, f32x4 c) { return __builtin_amdgcn_mfma_f32_16x16x32_bf16(a, b, c, 0, 0, 0); }
__device__ __forceinline__ bf16x8 pack8(f32x4 a, f32x4 b) {
    u32x4 w; w.x = cvt_pk_bf16(a[0], a[1]); w.y = cvt_pk_bf16(a[2], a[3]); w.z = cvt_pk_bf16(b[0], b[1]); w.w = cvt_pk_bf16(b[2], b[3]);
    return __builtin_bit_cast(bf16x8, w); }
__device__ __forceinline__ bf16x8 cat4(bf16x4 a, bf16x4 b) { return __builtin_shufflevector(a, b, 0, 1, 2, 3, 4, 5, 6, 7); }
__device__ __forceinline__ u32x2 pack4(f32x4 a) { u32x2 w; w.x = cvt_pk_bf16(a[0], a[1]); w.y = cvt_pk_bf16(a[2], a[3]); return w; }
__device__ __forceinline__ f32x4 unpack4(u32x2 w) { return (f32x4){bflo(w.x), bfhi(w.x), bflo(w.y), bfhi(w.y)}; }
__device__ __forceinline__ float log_sigmoid(float x) { return fminf(x, 0.f) - log1pf(expf(-fabsf(x))); }

__device__ __forceinline__ float row_rstd(const float* ssq, int row, int fq) {
    const f32x4* q = (const f32x4*)(ssq + (size_t)row * 32 + fq * 8);
    const f32x4 a = q[0], b = q[1];
    float s = ((a[0] + a[1]) + (a[2] + a[3])) + ((b[0] + b[1]) + (b[2] + b[3]));
    s += __shfl_xor(s, 16); s += __shfl_xor(s, 32);
    return rsqrtf(s * (1.0f / 2048.0f) + 1e-6f);
}

struct EpiZ {
    static constexpr bool PERM = true, AFTER_DRAIN = false, HAS_MID = false;
    bf16_t* Z; const float* ssq; const float* rope;
    __device__ __forceinline__ void operator()(const f32x4 (&acc)[2][2][4][2], const Unit& u, int wr, int wc, int fr, int fq) const {
        const int pn = u.pn;
        int mode = 0; float scl = 1.f;
        if (pn < 2) mode = 0; else if (pn < 4) scl = 0.08838834764831845f; else if (pn < 6) mode = 1; else if (pn < 14) { mode = 2; if (pn < 10) scl = 0.08838834764831845f * 1.4426950408889634f; } else if (pn < 16) mode = 3; else mode = 1;
        const bool rot = (mode == 2) && (wc == 0);
        const float sg = (fq < 2) ? -1.f : 1.f;
        const int row0 = u.pm * 256 + wr * 64 + fr, col0 = pn * 256 + wc * 32 + 8 * fq;
        float rsv[2][4];
#pragma unroll
        for (int ai = 0; ai < 2; ++ai)
#pragma unroll
            for (int m = 0; m < 4; ++m) rsv[ai][m] = row_rstd(ssq, row0 + ai * 128 + m * 16, fq) * scl;
#pragma unroll
        for (int ai = 0; ai < 2; ++ai)
#pragma unroll
            for (int m = 0; m < 4; ++m) {
                const int row = row0 + ai * 128 + m * 16;
                const float rs = rsv[ai][m];
                bf16_t* rowp = Z + (size_t)row * NZ + col0;
                f32x4 cs0 = {0.f, 0.f, 0.f, 0.f}, cs1 = cs0, cs2 = cs0, cs3 = cs0;
                if (rot) { const f32x4* rp = (const f32x4*)(rope + ((size_t)(row & (SEQ - 1)) * 16 + 8 * (fq & 1)) * 2); cs0 = rp[0]; cs1 = rp[1]; cs2 = rp[2]; cs3 = rp[3]; }
#pragma unroll
                for (int bj = 0; bj < 2; ++bj) {
                    f32x4 v0 = acc[ai][bj][m][0] * rs, v1 = acc[ai][bj][m][1] * rs;
                    if (mode == 1) {
#pragma unroll
                        for (int j = 0; j < 4; ++j) { v0[j] = sigm(v0[j]); v1[j] = sigm(v1[j]); } }
                    if (mode == 3) {
#pragma unroll
                        for (int j = 0; j < 4; ++j) { v0[j] = gelu_t(v0[j]); v1[j] = gelu_t(v1[j]); } }
                    if (rot) {
                        f32x4 p0, p1;
#pragma unroll
                        for (int j = 0; j < 4; ++j) { p0[j] = __shfl_xor(v0[j], 32); p1[j] = __shfl_xor(v1[j], 32); }
                        f32x4 o0, o1;
                        o0[0] = v0[0] * cs0[0] + sg * p0[0] * cs0[1]; o0[1] = v0[1] * cs0[2] + sg * p0[1] * cs0[3];
                        o0[2] = v0[2] * cs1[0] + sg * p0[2] * cs1[1]; o0[3] = v0[3] * cs1[2] + sg * p0[3] * cs1[3];
                        o1[0] = v1[0] * cs2[0] + sg * p1[0] * cs2[1]; o1[1] = v1[1] * cs2[2] + sg * p1[1] * cs2[3];
                        o1[2] = v1[2] * cs3[0] + sg * p1[2] * cs3[1]; o1[3] = v1[3] * cs3[2] + sg * p1[3] * cs3[3];
                        v0 = o0; v1 = o1;
                    }
                    *(bf16x8*)(rowp + bj * 128) = pack8(v0, v1);
                }
            }
    }
};
struct EpiZT {
    static constexpr bool PERM = true, AFTER_DRAIN = false, HAS_MID = false;
    bf16_t* ZT; const float* ssq;
    __device__ __forceinline__ void operator()(const f32x4 (&acc)[2][2][4][2], const Unit& u, int wr, int wc, int fr, int fq) const {
        const bool gel = u.pm >= 6;
        const int lane = fq * 16 + fr;
        const int tokL = u.pn * 256 + 128 * (lane >> 5) + 32 * wc + (lane & 31);
        const f32x4* q = (const f32x4*)(ssq + (size_t)tokL * 32);
        float s = 0.f;
#pragma unroll
        for (int i = 0; i < 8; ++i) { const f32x4 a = q[i]; s += (a[0] + a[1]) + (a[2] + a[3]); }
        const float rsL = rsqrtf(s * (1.0f / 2048.0f) + 1e-6f);
        f32x4 rsv[2][2];
#pragma unroll
        for (int bj = 0; bj < 2; ++bj)
#pragma unroll
            for (int n = 0; n < 2; ++n)
#pragma unroll
                for (int i = 0; i < 4; ++i) rsv[bj][n][i] = __shfl(rsL, bj * 32 + 8 * fq + 4 * n + i);
        const int row0 = u.pm * 256 + wr * 64 + fr, col0 = u.pn * 256 + wc * 32 + 8 * fq;
#pragma unroll
        for (int ai = 0; ai < 2; ++ai)
#pragma unroll
            for (int m = 0; m < 4; ++m) {
                bf16_t* rowp = ZT + (size_t)(row0 + ai * 128 + m * 16) * MT + col0;
#pragma unroll
                for (int bj = 0; bj < 2; ++bj) {
                    f32x4 v0 = acc[ai][bj][m][0] * rsv[bj][0], v1 = acc[ai][bj][m][1] * rsv[bj][1];
                    if (gel) {
#pragma unroll
                        for (int j = 0; j < 4; ++j) { v0[j] = gelu_t(v0[j]); v1[j] = gelu_t(v1[j]); } }
                    *(bf16x8*)(rowp + bj * 128) = pack8(v0, v1);
                }
            }
    }
};
struct MergeOrder : pg8::StaticOrder {
    __host__ __device__ bool next(int i, Unit& u) const { const int q = i / 3, seg = i - 3 * q; if (!pg8::StaticOrder::next(q, u)) return false; u.kt0 = seg == 0 ? 0 : (seg == 1 ? 8 : 24); u.nkt = seg == 1 ? 16 : 8; u.zero = seg == 2; return true; }
};
struct EpiMerge {
    static constexpr bool PERM = true, AFTER_DRAIN = false, HAS_MID = true;
    const bf16_t* Z; bf16_t* mergedb;
    __device__ __forceinline__ void mid(f32x4 (&acc)[2][2][4][2], const Unit& u, int wr, int wc, int fr, int fq) const {
        if (u.zero) { (*this)(acc, u, wr, wc, fr, fq); return; }
        const int which = u.kt0 == 0 ? 0 : 1;
        const int row0 = u.pm * 256 + wr * 64 + fr, col0 = u.pn * 256 + wc * 32 + 8 * fq;
#pragma unroll
        for (int ai = 0; ai < 2; ++ai)
#pragma unroll
            for (int mp = 0; mp < 2; ++mp) {
                u32x4 nu[2][2], de[2][2];
#pragma unroll
                for (int mm = 0; mm < 2; ++mm)
#pragma unroll
                    for (int bj = 0; bj < 2; ++bj) {
                        const bf16_t* gp = Z + (size_t)(row0 + ai * 128 + (2 * mp + mm) * 16) * NZ + ZG + which * 2048 + col0 + bj * 128;
                        nu[mm][bj] = *(const u32x4*)gp; de[mm][bj] = *(const u32x4*)(gp + 2048);
                    }
                asm volatile("" ::: "memory");
#pragma unroll
                for (int mm = 0; mm < 2; ++mm)
#pragma unroll
                    for (int bj = 0; bj < 2; ++bj) {
                        const u32x4 n_ = nu[mm][bj], d_ = de[mm][bj];
                        f32x4 r0, r1;
                        r0[0] = bflo(n_.x) * __builtin_amdgcn_rcpf(bflo(d_.x)); r0[1] = bfhi(n_.x) * __builtin_amdgcn_rcpf(bfhi(d_.x));
                        r0[2] = bflo(n_.y) * __builtin_amdgcn_rcpf(bflo(d_.y)); r0[3] = bfhi(n_.y) * __builtin_amdgcn_rcpf(bfhi(d_.y));
                        r1[0] = bflo(n_.z) * __builtin_amdgcn_rcpf(bflo(d_.z)); r1[1] = bfhi(n_.z) * __builtin_amdgcn_rcpf(bfhi(d_.z));
                        r1[2] = bflo(n_.w) * __builtin_amdgcn_rcpf(bflo(d_.w)); r1[3] = bfhi(n_.w) * __builtin_amdgcn_rcpf(bfhi(d_.w));
                        acc[ai][bj][2 * mp + mm][0] *= r0; acc[ai][bj][2 * mp + mm][1] *= r1;
                    }
            }
    }
    __device__ __forceinline__ void operator()(const f32x4 (&acc)[2][2][4][2], const Unit& u, int wr, int wc, int fr, int fq) const {
        const int row0 = u.pm * 256 + wr * 64 + fr, col0 = u.pn * 256 + wc * 32 + 8 * fq;
#pragma unroll
        for (int ai = 0; ai < 2; ++ai) {
            u32x4 gcv[4][2];
#pragma unroll
            for (int m = 0; m < 4; ++m)
#pragma unroll
                for (int bj = 0; bj < 2; ++bj) gcv[m][bj] = *(const u32x4*)(Z + (size_t)(row0 + ai * 128 + m * 16) * NZ + ZG + 2 * 2048 + col0 + bj * 128);
#pragma unroll
            for (int m = 0; m < 4; ++m) {
                const int row = row0 + ai * 128 + m * 16;
#pragma unroll
                for (int bj = 0; bj < 2; ++bj) {
                    const u32x4 gc = gcv[m][bj];
                    const f32x4 g0 = {bflo(gc.x), bfhi(gc.x), bflo(gc.y), bfhi(gc.y)}, g1 = {bflo(gc.z), bfhi(gc.z), bflo(gc.w), bfhi(gc.w)};
                    *(bf16x8*)(mergedb + (size_t)row * DM + col0 + bj * 128) = pack8(acc[ai][bj][m][0] * g0, acc[ai][bj][m][1] * g1);
                }
            }
        }
    }
};
template <int MODE> struct EpiRes {
    static constexpr bool PERM = true, AFTER_DRAIN = false, HAS_MID = false;
    static constexpr int NB = MODE == 1 ? 1 : 2;
    const float* base; float* out; bf16_t* xb; float* ssq_out; const float* ssq_in; const bf16_t* P;
    __device__ __forceinline__ void operator()(const f32x4 (&acc)[2][2][4][2], const Unit& u, int wr, int wc, int fr, int fq) const {
        const int row0 = u.pm * 256 + wr * 64 + fr, col0 = u.pn * 256 + wc * 32 + 8 * fq;
        float rsv[2][4];
        if (MODE == 1) {
#pragma unroll
            for (int ai = 0; ai < 2; ++ai)
#pragma unroll
                for (int m = 0; m < 4; ++m) rsv[ai][m] = row_rstd(ssq_in, row0 + ai * 128 + m * 16, fq);
        }
#pragma unroll
        for (int ai = 0; ai < 2; ++ai)
#pragma unroll
            for (int mp = 0; mp < 4 / NB; ++mp) {
                f32x4 bv[NB][2][2]; u32x4 pv[NB][2];
#pragma unroll
                for (int mm = 0; mm < NB; ++mm)
#pragma unroll
                    for (int bj = 0; bj < 2; ++bj) {
                        const size_t off = (size_t)(row0 + ai * 128 + (NB * mp + mm) * 16) * DM + col0 + bj * 128;
                        bv[mm][bj][0] = *(const f32x4*)(base + off); bv[mm][bj][1] = *(const f32x4*)(base + off + 4);
                        if (MODE == 1) pv[mm][bj] = *(const u32x4*)(P + off);
                    }
#pragma unroll
                for (int mm = 0; mm < NB; ++mm) {
                    const int m = NB * mp + mm, row = row0 + ai * 128 + m * 16;
                    float ss = 0.f;
#pragma unroll
                    for (int bj = 0; bj < 2; ++bj) {
                        const size_t off = (size_t)row * DM + col0 + bj * 128;
                        f32x4 d0 = acc[ai][bj][m][0], d1 = acc[ai][bj][m][1];
                        if (MODE == 1) { const u32x4 pw = pv[mm][bj];
                            const f32x4 p0 = {bflo(pw.x), bfhi(pw.x), bflo(pw.y), bfhi(pw.y)}, p1 = {bflo(pw.z), bfhi(pw.z), bflo(pw.w), bfhi(pw.w)};
#pragma unroll
                            for (int j = 0; j < 4; ++j) { d0[j] = sigm(d0[j] * rsv[ai][m]) * p0[j]; d1[j] = sigm(d1[j] * rsv[ai][m]) * p1[j]; } }
                        const f32x4 x0 = bv[mm][bj][0] + d0, x1 = bv[mm][bj][1] + d1;
                        *(f32x4*)(out + off) = x0; *(f32x4*)(out + off + 4) = x1;
                        if (xb) *(bf16x8*)(xb + off) = pack8(x0, x1);
                        ss += ((x0[0] * x0[0] + x0[1] * x0[1]) + (x0[2] * x0[2] + x0[3] * x0[3])) + ((x1[0] * x1[0] + x1[1] * x1[1]) + (x1[2] * x1[2] + x1[3] * x1[3]));
                    }
                    ss += __shfl_xor(ss, 16); ss += __shfl_xor(ss, 32);
                    if (fq == 0) ssq_out[(size_t)row * 32 + u.pn * 4 + wc] = ss;
                }
            }
    }
};
struct EpiUp {
    static constexpr bool PERM = true, AFTER_DRAIN = false, HAS_MID = false;
    bf16_t* H; const float* ssq;
    __device__ __forceinline__ void operator()(const f32x4 (&acc)[2][2][4][2], const Unit& u, int wr, int wc, int fr, int fq) const {
        const int row0 = u.pm * 256 + wr * 64 + fr, col0 = u.pn * 256 + wc * 32 + 8 * fq;
        float rsv[2][4];
#pragma unroll
        for (int ai = 0; ai < 2; ++ai)
#pragma unroll
            for (int m = 0; m < 4; ++m) rsv[ai][m] = row_rstd(ssq, row0 + ai * 128 + m * 16, fq);
#pragma unroll
        for (int ai = 0; ai < 2; ++ai)
#pragma unroll
            for (int m = 0; m < 4; ++m) {
                const int row = row0 + ai * 128 + m * 16;
                const float rs = rsv[ai][m];
                bf16_t* rowp = H + (size_t)row * FF + col0;
#pragma unroll
                for (int bj = 0; bj < 2; ++bj) {
                    f32x4 v0 = acc[ai][bj][m][0] * rs, v1 = acc[ai][bj][m][1] * rs;
#pragma unroll
                    for (int j = 0; j < 4; ++j) { const float a = fmaxf(v0[j], 0.f), b = fmaxf(v1[j], 0.f); v0[j] = a * a; v1[j] = b * b; }
                    *(bf16x8*)(rowp + bj * 128) = pack8(v0, v1);
                }
            }
    }
};
struct EpiP {
    static constexpr bool PERM = true, AFTER_DRAIN = false, HAS_MID = false;
    bf16_t* O; int ldc;
    __device__ __forceinline__ void operator()(const f32x4 (&acc)[2][2][4][2], const Unit& u, int wr, int wc, int fr, int fq) const {
        const int row0 = u.pm * 256 + wr * 64 + fr, col0 = u.pn * 256 + wc * 32 + 8 * fq;
#pragma unroll
        for (int ai = 0; ai < 2; ++ai)
#pragma unroll
            for (int m = 0; m < 4; ++m) {
                bf16_t* rowp = O + (size_t)(row0 + ai * 128 + m * 16) * ldc + col0;
#pragma unroll
                for (int bj = 0; bj < 2; ++bj) *(bf16x8*)(rowp + bj * 128) = pack8(acc[ai][bj][m][0], acc[ai][bj][m][1]);
            }
    }
};

template <class Epi, class Order = pg8::StaticOrder> __device__ __forceinline__ void run_gemm(LAS unsigned char* lds, const bf16_t* A, const bf16_t* Bt, int M, int N, int K, const Epi& E) {
    __syncthreads();
    pg8::Gemm g{A, Bt, M, N, K}; Order S; S.init(M, N, (int)gridDim.x, (int)blockIdx.x, K);
    pg8::gemm_phase<Epi, Order, false>(lds, g, S, E, nullptr);
    __syncthreads();
}

struct CvtSeg { const float* src; int ld; const float* gain; bf16_t* dst; int K, N, ldd; };
constexpr int CVT_TILES_L = 4384, CVT_TILES = 2 * CVT_TILES_L;
__device__ __forceinline__ CvtSeg cvt_get(const Params& p, int gt, int& lt) {
    const int l = gt >= CVT_TILES_L ? 1 : 0; int t = gt - l * CVT_TILES_L;
    const float* win = p.in[3] + (size_t)l * 2048 * WIN_LD; bf16_t* wti = ((bf16_t*)(p.ws + OFF_wt_in)) + (size_t)l * NWIN * 2048; const float* gm = p.in[2] + l * 2048;
    bf16_t* wcat = ((bf16_t*)(p.ws + OFF_wt_a)) + (size_t)l * 2048 * 2048;
#define CVT_SEG(NT, ...) if (t < (NT)) { lt = t; return CvtSeg{__VA_ARGS__}; } t -= (NT);
    CVT_SEG(64,  win + 0,    WIN_LD, gm, wti + (size_t)0 * 2048,     2048, 512, 2048)
    CVT_SEG(64,  win + 512,  WIN_LD, gm, wti + (size_t)512 * 2048,   2048, 512, 2048)
    CVT_SEG(64,  win + 1536, WIN_LD, gm, wti + (size_t)1024 * 2048,  2048, 512, 2048)
    CVT_SEG(128, win + 2056, WIN_LD, gm, wti + (size_t)1536 * 2048,  2048, 1024, 2048)
    CVT_SEG(128, win + 3080, WIN_LD, gm, wti + (size_t)2560 * 2048,  2048, 1024, 2048)
    CVT_SEG(64,  win + 5128, WIN_LD, gm, wti + (size_t)3584 * 2048,  2048, 512, 2048)
    CVT_SEG(768, win + 6152, WIN_LD, gm, wti + (size_t)4096 * 2048,  2048, 6144, 2048)
    CVT_SEG(64,  win + 1024, WIN_LD, gm, wti + (size_t)10240 * 2048, 2048, 512, 2048)
    CVT_SEG(128, win + 4104, WIN_LD, gm, wti + (size_t)10752 * 2048, 2048, 1024, 2048)
    CVT_SEG(64,  win + 5640, WIN_LD, gm, wti + (size_t)11776 * 2048, 2048, 512, 2048)
    CVT_SEG(64,  p.in[10] + (size_t)l * 512 * 2048,  2048, nullptr, wcat + 0,    512, 2048, 2048)
    CVT_SEG(128, p.in[11] + (size_t)l * 1024 * 2048, 2048, nullptr, wcat + 512,  1024, 2048, 2048)
    CVT_SEG(64,  p.in[12] + (size_t)l * 512 * 2048,  2048, nullptr, wcat + 1536, 512, 2048, 2048)
    CVT_SEG(256, p.in[13] + (size_t)l * 2048 * 2048, 2048, nullptr, ((bf16_t*)(p.ws + OFF_wt_out)) + (size_t)l * 2048 * 2048, 2048, 2048, 2048)
    CVT_SEG(1024, p.in[15] + (size_t)l * 2048 * 8192, 8192, p.in[14] + l * 2048, ((bf16_t*)(p.ws + OFF_wt_up)) + (size_t)l * 8192 * 2048, 2048, 8192, 2048)
    CVT_SEG(1024, p.in[16] + (size_t)l * 8192 * 2048, 2048, nullptr, ((bf16_t*)(p.ws + OFF_wt_down)) + (size_t)l * 2048 * 8192, 8192, 2048, 8192)
    CVT_SEG(256, p.in[18] + (size_t)l * 2048 * 2048, 2048, p.in[17] + l * 2048, ((bf16_t*)(p.ws + OFF_wt_pg)) + (size_t)l * 2048 * 2048, 2048, 2048, 2048)
#undef CVT_SEG
    lt = t; return CvtSeg{p.in[19] + (size_t)l * 256 * 2048, 2048, nullptr, ((bf16_t*)(p.ws + OFF_wt_pe)) + (size_t)l * 2048 * 256, 256, 2048, 256};
}
__device__ __forceinline__ void cvt_load(const CvtSeg& sg, int t, int tid, f32x4 (&r)[8]) {
    const int nnt = sg.N >> 8, q_ = t >> 2; const int kt = (q_ / nnt) * 4 + (t & 3), nt = q_ % nnt;
    const float* base = sg.src + (size_t)(kt * 64 + (tid >> 6)) * sg.ld + nt * 256 + (tid & 63) * 4;
#pragma unroll
    for (int i = 0; i < 8; ++i) r[i] = __builtin_nontemporal_load((const f32x4*)(base + (size_t)(8 * i) * sg.ld));
}
__device__ __forceinline__ void cvt_step(const Params& p, LAS bf16_t* T, CvtSeg& sg, int& lt, f32x4 (&r)[8], int gnext, int tid) {
    const int nnt = sg.N >> 8, q_ = lt >> 2; const int kt = (q_ / nnt) * 4 + (lt & 3), nt = q_ % nnt;
#pragma unroll
    for (int i = 0; i < 8; ++i) { const int k = (tid >> 6) + 8 * i; f32x4 v = r[i]; if (sg.gain) v = v * sg.gain[kt * 64 + k];
        const u32x2 w = pack4(v); LAS unsigned* q = (LAS unsigned*)(T + k * 258 + (tid & 63) * 4); q[0] = w.x; q[1] = w.y; }
    bf16_t* const dst = sg.dst; const int ldd = sg.ldd;
    __syncthreads();
    if (gnext < CVT_TILES) { sg = cvt_get(p, gnext, lt); cvt_load(sg, lt, tid, r); }
#pragma unroll
    for (int j = 0; j < 4; ++j) { const int n = (tid >> 3) + 64 * j, kc = (tid & 7) * 8;
        unsigned short e[8];
#pragma unroll
        for (int q = 0; q < 8; ++q) e[q] = T[(kc + q) * 258 + n];
        u32x4 w; w.x = e[0] | ((unsigned)e[1] << 16); w.y = e[2] | ((unsigned)e[3] << 16); w.z = e[4] | ((unsigned)e[5] << 16); w.w = e[6] | ((unsigned)e[7] << 16);
        *(u32x4*)(dst + (size_t)(nt * 256 + n) * ldd + kt * 64 + kc) = w; }
}
__device__ __forceinline__ void cvt_all(const Params& p, LAS unsigned char* lds, int tid) {
    LAS bf16_t* T = (LAS bf16_t*)lds;
    const int G = gridDim.x, bid = blockIdx.x;
#define CVT_GT(i) (4 * (bid + ((i) >> 2) * G) + ((i) & 3))
    f32x4 ra[8], rb[8]; CvtSeg sa, sb; int la = 0, lb = 0;
    sa = cvt_get(p, CVT_GT(0) < CVT_TILES ? CVT_GT(0) : 0, la); sb = cvt_get(p, CVT_GT(1) < CVT_TILES ? CVT_GT(1) : 0, lb);
    if (CVT_GT(0) < CVT_TILES) cvt_load(sa, la, tid, ra);
    if (CVT_GT(1) < CVT_TILES) cvt_load(sb, lb, tid, rb);
    for (int i = 0; CVT_GT(i) < CVT_TILES; i += 2) {
        cvt_step(p, T, sa, la, ra, CVT_GT(i + 2), tid);
        if (CVT_GT(i + 1) < CVT_TILES) cvt_step(p, T + 64 * 258, sb, lb, rb, CVT_GT(i + 3), tid);
    }
#undef CVT_GT
    __syncthreads();
}
__device__ __forceinline__ void prologue(const Params& p, LAS unsigned char* lds, int tid) {
    const int gid = blockIdx.x * 512 + tid, gsz = gridDim.x * 512;
    for (int i = gid; i < SEQ * 16; i += gsz) {
        const int pos = i >> 4, j = i & 15;
        const float inv = exp2f(-(float)j * (1.0f / 16.0f) * 18.931568569324174f);
        const float ang = (float)pos * inv;
        const double rev = (double)ang * 0.15915494309189535;
        const float fr = (float)(rev - floor(rev));
        ((float*)(p.ws + OFF_rope))[2 * i] = __builtin_amdgcn_cosf(fr); ((float*)(p.ws + OFF_rope))[2 * i + 1] = __builtin_amdgcn_sinf(fr);
    }
    for (int i = gid; i < 2 * 2048 * 8; i += gsz) { const int l = i >> 14, k = (i >> 3) & 2047, j = i & 7; ((float*)(p.ws + OFF_gw))[i] = p.in[3][((size_t)l * 2048 + k) * WIN_LD + 2048 + j] * p.in[2][l * 2048 + k]; }
    for (int i = gid; i < 2 * MT * 256 / 4; i += gsz) { const f32x4 v = ((const f32x4*)p.in[1])[i]; ((u32x2*)((bf16_t*)(p.ws + OFF_pb)))[i] = pack4(v); }
    { const int lane = tid & 63, w = tid >> 6;
      for (int row = blockIdx.x * 8 + w; row < MT; row += gridDim.x * 8) {
          float ss = 0.f;
#pragma unroll
          for (int i = 0; i < 8; ++i) { const int k = 4 * lane + 256 * i; const f32x4 v = *(const f32x4*)(p.in[0] + (size_t)row * DM + k); ss += (v[0] * v[0] + v[1] * v[1]) + (v[2] * v[2] + v[3] * v[3]); *(u32x2*)(((bf16_t*)(p.ws + OFF_xb0)) + (size_t)row * DM + k) = pack4(v); }
          ss = wave_sum(ss);
          if (lane < 32) ((float*)(p.ws + OFF_ssq0))[(size_t)row * 32 + lane] = lane == 0 ? ss : 0.f;
      } }
    cvt_all(p, lds, tid);
}

__device__ __forceinline__ void gates_phase(const Params& p, int layer, const float* xsrc, int tid) {
    const int lane = tid & 63, w = tid >> 6;
    const float* gwt = ((float*)(p.ws + OFF_gw)) + (size_t)layer * 2048 * 8;
    for (int r0 = blockIdx.x * 8 + w; r0 < 2048; r0 += gridDim.x * 8) {
        float acc[4][8]; float ss[4];
#pragma unroll
        for (int i = 0; i < 4; ++i) { ss[i] = 0.f;
#pragma unroll
            for (int j = 0; j < 8; ++j) acc[i][j] = 0.f; }
        for (int kk = 0; kk < 8; ++kk) {
            const int k = 4 * lane + 256 * kk;
            f32x4 xv[4];
#pragma unroll
            for (int i = 0; i < 4; ++i) { xv[i] = *(const f32x4*)(xsrc + (size_t)(r0 + 2048 * i) * DM + k); ss[i] += (xv[i][0] * xv[i][0] + xv[i][1] * xv[i][1]) + (xv[i][2] * xv[i][2] + xv[i][3] * xv[i][3]); }
#pragma unroll
            for (int kq = 0; kq < 4; ++kq) {
                const f32x4 w0 = *(const f32x4*)(gwt + (size_t)(k + kq) * 8), w1 = *(const f32x4*)(gwt + (size_t)(k + kq) * 8 + 4);
#pragma unroll
                for (int i = 0; i < 4; ++i) { const float xx = xv[i][kq];
#pragma unroll
                    for (int j = 0; j < 4; ++j) { acc[i][j] += xx * w0[j]; acc[i][4 + j] += xx * w1[j]; } }
            }
        }
#pragma unroll
        for (int i = 0; i < 4; ++i) {
            const float rs = rsqrtf(wave_sum(ss[i]) * (1.0f / 2048.0f) + 1e-6f);
            float outv = 0.f;
#pragma unroll
            for (int j = 0; j < 8; ++j) { const float v = wave_sum(acc[i][j]); if (lane == j) outv = v * rs + p.in[4][layer * 8 + j]; }
            if (lane < 8) ((float*)(p.ws + OFF_GT))[(size_t)(r0 + 2048 * i) * 8 + lane] = outv;
        }
    }
}

__device__ __forceinline__ void mlstm_a_unit(const Params& p, LAS unsigned char* lds, int unit, int tid) {
    const int bh = unit >> 6, c = unit & 63, b = bh >> 2, h = bh & 3;
    const int tok0 = b * SEQ + c * 64;
    const int lane = tid & 63, w = tid >> 6, fr = lane & 15, g4 = lane >> 4;
    LAS bf16_t* KT = (LAS bf16_t*)lds;
    const bf16_t* vt = ((bf16_t*)(p.ws + OFF_ZT)) + (size_t)(TVA + h * 128 + 16 * w + fr) * MT + tok0 + 8 * g4;
    const bf16x8 A0 = *(const bf16x8*)vt, A1 = *(const bf16x8*)(vt + 32);
    const float ig = ((float*)(p.ws + OFF_GT))[(size_t)(tok0 + lane) * 8 + h], fp = ((float*)(p.ws + OFF_GT))[(size_t)(tok0 + lane) * 8 + 4 + h];
    const float g = wave_scan_add(log_sigmoid(fp), lane);
    const float glast = __shfl(g, 63);
    const float lu = glast - g + ig;
    const float mloc = wave_max(lu);
    const float uu = expf(lu - mloc);
    { const int l = tid >> 3, kc = (tid & 7) * 16;
      const float ul = __shfl(uu, l);
      const u32x4* src = (const u32x4*)(((bf16_t*)(p.ws + OFF_Z)) + (size_t)(tok0 + l) * NZ + ZKA + h * 128 + kc);
      const u32x4 a = src[0], bq = src[1];
      const unsigned wd[8] = {a.x, a.y, a.z, a.w, bq.x, bq.y, bq.z, bq.w};
#pragma unroll
      for (int e = 0; e < 8; ++e) { KT[(kc + 2 * e) * 72 + l] = f2bf(bflo(wd[e]) * ul); KT[(kc + 2 * e + 1) * 72 + l] = f2bf(bfhi(wd[e]) * ul); } }
    __syncthreads();
    if (tid < 128) {
        float s = 0.f; const LAS bf16x8* r = (const LAS bf16x8*)(KT + tid * 72);
#pragma unroll
        for (int i = 0; i < 8; ++i) { const bf16x8 v = r[i];
#pragma unroll
            for (int e = 0; e < 8; ++e) s += bf2f((bf16_t)v[e]); }
        ((float*)(p.ws + OFF_dn))[((size_t)bh * 64 + c) * 128 + tid] = s;
    }
    f32x4 acc[8];
#pragma unroll
    for (int kt = 0; kt < 8; ++kt) acc[kt] = (f32x4){0.f, 0.f, 0.f, 0.f};
#pragma unroll
    for (int kt = 0; kt < 8; ++kt) {
        const LAS bf16_t* kb = KT + (16 * kt + fr) * 72 + 8 * g4;
        const bf16x8 B0 = *(const LAS bf16x8*)kb, B1 = *(const LAS bf16x8*)(kb + 32);
        acc[kt] = mfma16(A0, B0, acc[kt]); acc[kt] = mfma16(A1, B1, acc[kt]);
    }
    float* dst = ((float*)(p.ws + OFF_dC)) + ((size_t)bh * 64 + c) * 16384;
#pragma unroll
    for (int kt = 0; kt < 8; ++kt)
#pragma unroll
        for (int j = 0; j < 4; ++j) dst[(16 * w + 4 * g4 + j) * 128 + 16 * kt + fr] = acc[kt][j];
    if (tid == 0) { ((float*)(p.ws + OFF_gsc))[(bh * 64 + c) * 2] = glast; ((float*)(p.ws + OFF_gsc))[(bh * 64 + c) * 2 + 1] = mloc; }
    __syncthreads();
}
__device__ __forceinline__ void mlstm_scan(const Params& p, int tid) {
    const int total = 8 * 16512, lane = tid & 63;
    for (int e = blockIdx.x * 512 + tid; e < total; e += gridDim.x * 512) {
        const int bh = e / 16512, r = e - bh * 16512;
        const float gl = ((float*)(p.ws + OFF_gsc))[(bh * 64 + lane) * 2], ml = ((float*)(p.ws + OFF_gsc))[(bh * 64 + lane) * 2 + 1];
        const float G = wave_scan_add(gl, lane);
        const float mc = G + fmaxf(0.f, wave_scan_max(ml - G, lane));
        float mp = __shfl_up(mc, 1); if (lane == 0) mp = 0.f;
        const float ca = expf(gl + mp - mc), cb = expf(ml - mc);
        if (r == lane) ((float*)(p.ws + OFF_mprev))[bh * 64 + lane] = mp;
        const bool isC = r < 16384;
        const float* src = isC ? ((float*)(p.ws + OFF_dC)) + (size_t)bh * 64 * 16384 + r : ((float*)(p.ws + OFF_dn)) + (size_t)bh * 64 * 128 + (r - 16384);
        const int stride = isC ? 16384 : 128;
        float dv[64];
#pragma unroll
        for (int c = 0; c < 64; ++c) dv[c] = src[(size_t)c * stride];
        float st = 0.f;
#pragma unroll
        for (int c = 0; c < 64; ++c) {
            if (isC) ((bf16_t*)(p.ws + OFF_Cprev))[((size_t)bh * 64 + c) * 16384 + r] = f2bf(st); else ((float*)(p.ws + OFF_nprev))[((size_t)bh * 64 + c) * 128 + (r - 16384)] = st;
            st = __shfl(ca, c) * st + __shfl(cb, c) * dv[c];
        }
    }
}
__device__ __forceinline__ void mlstm_c_unit(const Params& p, LAS unsigned char* lds, int unit, int tid, int layer) {
    const int bh = unit >> 6, c = unit & 63, b = bh >> 2, h = bh & 3;
    const int tok0 = b * SEQ + c * 64;
    const int lane = tid & 63, w = tid >> 6, fr = lane & 15, g4 = lane >> 4;
    LAS float* sE = (LAS float*)lds; LAS float* sD = sE + 64; LAS float* sMr = sE + 128; LAS float* sSS = sE + 192;
    const float m0 = ((float*)(p.ws + OFF_mprev))[bh * 64 + c];
    const int lt = w & 3, vh = w >> 2;
    const int l = 16 * lt + fr;
    const bf16_t* qp = ((bf16_t*)(p.ws + OFF_Z)) + (size_t)(tok0 + l) * NZ + ZQA + h * 128 + 8 * g4;
    bf16x8 Q[4];
#pragma unroll
    for (int ks = 0; ks < 4; ++ks) Q[ks] = *(const bf16x8*)(qp + 32 * ks);
    if (w == 0) {
        const float ig = ((float*)(p.ws + OFF_GT))[(size_t)(tok0 + lane) * 8 + h], fp = ((float*)(p.ws + OFF_GT))[(size_t)(tok0 + lane) * 8 + 4 + h];
        const float g = wave_scan_add(log_sigmoid(fp), lane);
        const float d = ig - g;
        const float bm = wave_scan_max(d, lane);
        const float mrow = g + fmaxf(bm, m0);
        sE[lane] = g - mrow; sD[lane] = d; sMr[lane] = mrow;
    }
    __syncthreads();
    const float el = sE[l];
    f32x4 pv[4]; float dsum = 0.f;
#pragma unroll
    for (int st = 0; st < 4; ++st) {
        pv[st] = (f32x4){0.f, 0.f, 0.f, 0.f};
        if (st <= lt) {
            const bf16_t* kp = ((bf16_t*)(p.ws + OFF_Z)) + (size_t)(tok0 + 16 * st + fr) * NZ + ZKA + h * 128 + 8 * g4;
            f32x4 s = {0.f, 0.f, 0.f, 0.f};
#pragma unroll
            for (int ks = 0; ks < 4; ++ks) s = mfma16(*(const bf16x8*)(kp + 32 * ks), Q[ks], s);
#pragma unroll
            for (int j = 0; j < 4; ++j) { const int sidx = 16 * st + 4 * g4 + j; const float wgt = (sidx <= l) ? s[j] * expf(el + sD[sidx]) : 0.f; pv[st][j] = wgt; dsum += wgt; }
        }
    }
    dsum += __shfl_xor(dsum, 16); dsum += __shfl_xor(dsum, 32);
    bf16x8 PB[2]; PB[0] = pack8(pv[0], pv[1]); PB[1] = pack8(pv[2], pv[3]);
    float qn = 0.f;
    { const float* np = ((float*)(p.ws + OFF_nprev)) + ((size_t)bh * 64 + c) * 128 + 8 * g4;
#pragma unroll
      for (int ks = 0; ks < 4; ++ks) { const f32x4 n0 = *(const f32x4*)(np + 32 * ks), n1 = *(const f32x4*)(np + 32 * ks + 4);
#pragma unroll
          for (int e = 0; e < 4; ++e) { qn += n0[e] * bf2f((bf16_t)Q[ks][e]); qn += n1[e] * bf2f((bf16_t)Q[ks][4 + e]); } } }
    qn += __shfl_xor(qn, 16); qn += __shfl_xor(qn, 32);
    const float al = expf(el + m0);
    const float den = dsum + al * qn;
    const float inv = 1.0f / fmaxf(fabsf(den), expf(-sMr[l]));
    f32x4 hv[4]; float ss = 0.f;
    const bf16_t* cp = ((bf16_t*)(p.ws + OFF_Cprev)) + ((size_t)bh * 64 + c) * 16384;
#pragma unroll
    for (int vt = 0; vt < 4; ++vt) {
        const int vrow = 64 * vh + 16 * vt + fr;
        f32x4 nacc = {0.f, 0.f, 0.f, 0.f}, iacc = {0.f, 0.f, 0.f, 0.f};
        const bf16_t* vp = ((bf16_t*)(p.ws + OFF_ZT)) + (size_t)(TVA + h * 128 + vrow) * MT + tok0 + 4 * g4;
#pragma unroll
        for (int kk = 0; kk < 2; ++kk) if (2 * kk <= lt) { const bf16x4 a0 = *(const bf16x4*)(vp + 32 * kk), a1 = *(const bf16x4*)(vp + 32 * kk + 16); nacc = mfma16(cat4(a0, a1), PB[kk], nacc); }
        const bf16_t* cr = cp + (size_t)vrow * 128 + 8 * g4;
#pragma unroll
        for (int ks = 0; ks < 4; ++ks) iacc = mfma16(*(const bf16x8*)(cr + 32 * ks), Q[ks], iacc);
#pragma unroll
        for (int j = 0; j < 4; ++j) { const float hh = (nacc[j] + al * iacc[j]) * inv; hv[vt][j] = hh; ss += hh * hh; }
    }
    ss += __shfl_xor(ss, 16); ss += __shfl_xor(ss, 32);
    if (g4 == 0) sSS[w * 16 + fr] = ss;
    __syncthreads();
    const float tot = ss + sSS[(w ^ 4) * 16 + fr];
    const float rn = rsqrtf(tot * (1.0f / 128.0f) + 1e-6f);
#pragma unroll
    for (int vt = 0; vt < 4; ++vt) {
        const int v0 = 64 * vh + 16 * vt + 4 * g4;
        const f32x4 ng = *(const f32x4*)(p.in[5] + layer * 512 + h * 128 + v0);
        const f32x4 so = unpack4(*(const u32x2*)(((bf16_t*)(p.ws + OFF_Z)) + (size_t)(tok0 + l) * NZ + ZOA + h * 128 + v0));
        f32x4 y;
#pragma unroll
        for (int j = 0; j < 4; ++j) y[j] = hv[vt][j] * rn * ng[j] * so[j];
        *(u32x2*)(((bf16_t*)(p.ws + OFF_yA)) + (size_t)(tok0 + l) * 2048 + h * 128 + v0) = pack4(y);
    }
    __syncthreads();
}

__device__ __forceinline__ void kmean_unit(const Params& p, LAS unsigned char* lds, int unit, int tid) {
    const int bh = unit >> 4, j = unit & 15, b = bh >> 3, h = bh & 7;
    LAS float* red = (LAS float*)lds;
    const int dc = tid & 15, kg = tid >> 4;
    float a[8];
#pragma unroll
    for (int e = 0; e < 8; ++e) a[e] = 0.f;
    const bf16_t* src = ((bf16_t*)(p.ws + OFF_Z)) + (size_t)(b * SEQ + j * 256 + kg * 8) * NZ + ZKB + h * 128 + dc * 8;
#pragma unroll
    for (int i = 0; i < 8; ++i) { const u32x4 v = *(const u32x4*)(src + (size_t)i * NZ);
        a[0] += bflo(v.x); a[1] += bfhi(v.x); a[2] += bflo(v.y); a[3] += bfhi(v.y); a[4] += bflo(v.z); a[5] += bfhi(v.z); a[6] += bflo(v.w); a[7] += bfhi(v.w); }
#pragma unroll
    for (int e = 0; e < 8; ++e) red[kg * 128 + dc * 8 + e] = a[e];
    __syncthreads();
    if (tid < 128) { float s = 0.f;
#pragma unroll 8
        for (int g = 0; g < 32; ++g) s += red[g * 128 + tid];
        ((float*)(p.ws + OFF_kmean))[((size_t)bh * 16 + j) * 128 + tid] = s * (1.0f / 256.0f); }
    __syncthreads();
}
constexpr float MOBA_SC = 0.08838834764831845f * 1.4426950408889634f;
__device__ __forceinline__ void moba_gate_unit(const Params& p, LAS unsigned char* lds, int unit, int tid) {
    const int bh = unit >> 5, tile = unit & 31, b = bh >> 3, h = bh & 7, ib = tile >> 1;
    const int lane = tid & 63;
    LAS float* sKm = (LAS float*)lds;
    for (int i = tid; i < 2048; i += 512) sKm[(i >> 7) * 132 + (i & 127)] = ((float*)(p.ws + OFF_kmean))[(size_t)bh * 2048 + i];
    __syncthreads();
    const int row = tid >> 2, jq = tid & 3;
    const int srow = tile * 128 + row;
    const bf16_t* qp = ((bf16_t*)(p.ws + OFF_Z)) + (size_t)(b * SEQ + srow) * NZ + ZQB + h * 128;
    float sc4[4] = {0.f, 0.f, 0.f, 0.f};
    for (int d8 = 0; d8 < 16; ++d8) {
        const u32x4 qv = *(const u32x4*)(qp + 8 * d8);
        const f32x4 q0 = {bflo(qv.x), bfhi(qv.x), bflo(qv.y), bfhi(qv.y)}, q1 = {bflo(qv.z), bfhi(qv.z), bflo(qv.w), bfhi(qv.w)};
#pragma unroll
        for (int m = 0; m < 4; ++m) { const LAS float* km = sKm + (4 * m + jq) * 132 + 8 * d8; const f32x4 k0 = *(const LAS f32x4*)km, k1 = *(const LAS f32x4*)(km + 4);
            sc4[m] += (q0[0] * k0[0] + q0[1] * k0[1]) + (q0[2] * k0[2] + q0[3] * k0[3]) + (q1[0] * k1[0] + q1[1] * k1[1]) + (q1[2] * k1[2] + q1[3] * k1[3]); }
    }
    float sc[16];
#pragma unroll
    for (int m = 0; m < 4; ++m)
#pragma unroll
        for (int qq = 0; qq < 4; ++qq) sc[4 * m + qq] = __shfl(sc4[m], (lane & ~3) | qq);
    unsigned mask = 0;
#pragma unroll
    for (int r = 0; r < 3; ++r) { float best = -3.0e38f; int bi = -1;
#pragma unroll
        for (int j = 0; j < 16; ++j) if (j < ib && !((mask >> j) & 1u) && sc[j] > best) { best = sc[j]; bi = j; }
        if (bi >= 0) mask |= 1u << bi; }
    if (jq == 0) ((unsigned*)(p.ws + OFF_selm))[(size_t)bh * SEQ + srow] = mask;
    unsigned basev[15];
#pragma unroll
    for (int j = 0; j < 15; ++j) {
        basev[j] = 0u;
        if (j < ib) {
            const bool mine = (jq == 0) && ((mask >> j) & 1u);
            const unsigned long long bal = __ballot(mine ? 1 : 0);
            if (bal != 0ull && lane == __ffsll((long long)bal) - 1) basev[j] = atomicAdd(((unsigned*)(p.ws + OFF_cnt)) + bh * 16 + j, (unsigned)__popcll(bal));
        }
    }
#pragma unroll
    for (int j = 0; j < 15; ++j) {
        if (j < ib) {
            const bool mine = (jq == 0) && ((mask >> j) & 1u);
            const unsigned long long bal = __ballot(mine ? 1 : 0);
            if (bal != 0ull) {
                const unsigned base = __shfl(basev[j], __ffsll((long long)bal) - 1);
                if (mine) { const int rank = __popcll(bal & ((1ull << lane) - 1ull)); ((unsigned short*)(p.ws + OFF_list))[(size_t)(bh * 16 + j) * 4096 + base + rank] = (unsigned short)srow; }
            }
        }
    }
    __syncthreads();
}
template <bool OWN> __device__ __forceinline__ void moba_unit_body(const LAS bf16_t* Kb, const LAS bf16_t* Vb, const bf16x8 (&Q)[2][4], const int (&rowi)[2], int j, int ktn, int fr, int g4,
                                                                   f32x4 (&O)[2][8], float (&mrun)[2], float (&lrun)[2]) {
    for (int kt = 0; kt < ktn; ++kt) {
        const int key0 = j * 256 + kt * 64;
        const LAS bf16_t* Kc = Kb + (64 * kt) * 136 + fr * 136 + 8 * g4; const LAS bf16_t* Vc = Vb + 64 * kt + fr * 264 + 4 * g4;
        f32x4 S[2][4];
        bf16x8 kf[2][4];
#pragma unroll
        for (int ks = 0; ks < 4; ++ks) kf[0][ks] = *(const LAS bf16x8*)(Kc + 32 * ks);
#pragma unroll
        for (int st = 0; st < 4; ++st) {
            if (st < 3) {
#pragma unroll
                for (int ks = 0; ks < 4; ++ks) kf[(st + 1) & 1][ks] = *(const LAS bf16x8*)(Kc + (16 * (st + 1)) * 136 + 32 * ks);
            }
            S[0][st] = (f32x4){0.f, 0.f, 0.f, 0.f}; S[1][st] = S[0][st];
#pragma unroll
            for (int ks = 0; ks < 4; ++ks) { S[0][st] = mfma16(kf[st & 1][ks], Q[0][ks], S[0][st]); S[1][st] = mfma16(kf[st & 1][ks], Q[1][ks], S[1][st]); }
        }
        bf16x4 vf[2][4];
#pragma unroll
        for (int q = 0; q < 4; ++q) vf[0][q] = *(const LAS bf16x4*)(Vc + 16 * q);
        bf16x8 PB[2][2];
#pragma unroll
        for (int cg = 0; cg < 2; ++cg) {
            float mx = -1.0e30f;
#pragma unroll
            for (int st = 0; st < 4; ++st)
#pragma unroll
                for (int jj = 0; jj < 4; ++jj) {
                    if (OWN) { const int key = key0 + 16 * st + 4 * g4 + jj; S[cg][st][jj] = (key <= rowi[cg]) ? S[cg][st][jj] : -1.0e30f; }
                    mx = fmaxf(mx, S[cg][st][jj]); }
            mx = fmaxf(mx, __shfl_xor(mx, 16)); mx = fmaxf(mx, __shfl_xor(mx, 32));
            const float mnew = fmaxf(mrun[cg], mx);
            const float alpha = ex2(mrun[cg] - mnew);
            float psum = 0.f;
#pragma unroll
            for (int st = 0; st < 4; ++st)
#pragma unroll
                for (int jj = 0; jj < 4; ++jj) { float pe = ex2(S[cg][st][jj] - mnew); if (OWN) pe = (S[cg][st][jj] > -1.0e29f) ? pe : 0.f; S[cg][st][jj] = pe; psum += pe; }
            lrun[cg] = lrun[cg] * alpha + psum; mrun[cg] = mnew;
#pragma unroll
            for (int dt = 0; dt < 8; ++dt) O[cg][dt] *= alpha;
            PB[cg][0] = pack8(S[cg][0], S[cg][1]); PB[cg][1] = pack8(S[cg][2], S[cg][3]);
        }
#pragma unroll
        for (int dt = 0; dt < 8; ++dt) {
            if (dt < 7) {
#pragma unroll
                for (int q = 0; q < 4; ++q) vf[(dt + 1) & 1][q] = *(const LAS bf16x4*)(Vc + (16 * (dt + 1)) * 264 + 16 * q);
            }
#pragma unroll
            for (int kk = 0; kk < 2; ++kk) { const bf16x8 v8 = cat4(vf[dt & 1][2 * kk], vf[dt & 1][2 * kk + 1]);
                O[0][dt] = mfma16(v8, PB[0][kk], O[0][dt]); O[1][dt] = mfma16(v8, PB[1][kk], O[1][dt]); }
        }
    }
}
__device__ __forceinline__ void moba_attn_phase(const Params& p, LAS unsigned char* lds, int tid) {
    const int lane = tid & 63, w = tid >> 6, fr = lane & 15, g4 = lane >> 4;
    LAS int* sPre = (LAS int*)lds;
    LAS bf16_t* Kb = (LAS bf16_t*)(lds + 2048);
    LAS bf16_t* Vb = (LAS bf16_t*)(lds + 2048 + 69632);
    const unsigned* cntp = (const unsigned*)(p.ws + OFF_cnt);
    if (tid < 256) sPre[tid + 1] = 1 + (int)((cntp[tid] + 255u) >> 8);
    if (tid == 0) sPre[0] = 0;
    __syncthreads();
    if (tid < 64) {
        int v0 = sPre[4 * lane + 1], v1 = sPre[4 * lane + 2], v2 = sPre[4 * lane + 3], v3 = sPre[4 * lane + 4];
        v1 += v0; v2 += v1; v3 += v2;
        int tot = v3;
#pragma unroll
        for (int o = 1; o < 64; o <<= 1) { const int t = __shfl_up(tot, o); if (lane >= o) tot += t; }
        const int excl = tot - v3;
        sPre[4 * lane + 1] = v0 + excl; sPre[4 * lane + 2] = v1 + excl; sPre[4 * lane + 3] = v2 + excl; sPre[4 * lane + 4] = v3 + excl;
    }
    __syncthreads();
    const int nunits = sPre[256];
    const int u0 = (int)(((long)blockIdx.x * nunits) / gridDim.x), u1 = (int)(((long)(blockIdx.x + 1) * nunits) / gridDim.x);
    int cur_bhj = -1;
    for (int u = u0; u < u1; ++u) {
        int lo = 0, hi = 256;
        while (hi - lo > 1) { const int mid = (lo + hi) >> 1; if (sPre[mid] <= u) lo = mid; else hi = mid; }
        const int bhj = lo, c = u - sPre[lo];
        const int bh = bhj >> 4, j = bhj & 15, b = bh >> 3, h = bh & 7;
        if (bhj != cur_bhj) {
            __syncthreads();
            u32x4 rk[8], rv[8];
            const bf16_t* kg = ((bf16_t*)(p.ws + OFF_Z)) + (size_t)(b * SEQ + j * 256 + (tid >> 4)) * NZ + ZKB + h * 128 + (tid & 15) * 8;
            const bf16_t* vg = ((bf16_t*)(p.ws + OFF_ZT)) + (size_t)(TVB + h * 128 + (tid >> 5)) * MT + b * SEQ + j * 256 + (tid & 31) * 8;
#pragma unroll
            for (int i = 0; i < 8; ++i) { rk[i] = *(const u32x4*)(kg + (size_t)(32 * i) * NZ); rv[i] = *(const u32x4*)(vg + (size_t)(16 * i) * MT); }
#pragma unroll
            for (int i = 0; i < 8; ++i) { *(LAS u32x4*)(Kb + ((tid >> 4) + 32 * i) * 136 + (tid & 15) * 8) = rk[i]; *(LAS u32x4*)(Vb + ((tid >> 5) + 16 * i) * 264 + (tid & 31) * 8) = rv[i]; }
            __syncthreads();
            cur_bhj = bhj;
        }
        const int cnt = (int)cntp[bhj];
        const bool own = (c == 0);
        int rowi[2]; bool valid[2]; unsigned smv[2];
#pragma unroll
        for (int cg = 0; cg < 2; ++cg) {
            const int idx = 32 * w + 16 * cg + fr;
            if (own) { rowi[cg] = j * 256 + idx; valid[cg] = true; }
            else { const int li = 256 * (c - 1) + idx; valid[cg] = li < cnt; rowi[cg] = valid[cg] ? (int)((const unsigned short*)(p.ws + OFF_list))[(size_t)bhj * 4096 + li] : j * 256; }
        }
        bf16x8 Q[2][4];
#pragma unroll
        for (int cg = 0; cg < 2; ++cg) { const bf16_t* qp = ((bf16_t*)(p.ws + OFF_Z)) + (size_t)(b * SEQ + rowi[cg]) * NZ + ZQB + h * 128 + 8 * g4;
            smv[cg] = ((const unsigned*)(p.ws + OFF_selm))[(size_t)bh * SEQ + rowi[cg]];
#pragma unroll
            for (int ks = 0; ks < 4; ++ks) Q[cg][ks] = *(const bf16x8*)(qp + 32 * ks); }
        f32x4 O[2][8];
#pragma unroll
        for (int cg = 0; cg < 2; ++cg)
#pragma unroll
            for (int dt = 0; dt < 8; ++dt) O[cg][dt] = (f32x4){0.f, 0.f, 0.f, 0.f};
        float mrun[2] = {-1.0e30f, -1.0e30f}, lrun[2] = {0.f, 0.f};
        const int ktn = own ? ((32 * w + 31) >> 6) + 1 : 4;
        if (own) moba_unit_body<true>(Kb, Vb, Q, rowi, j, ktn, fr, g4, O, mrun, lrun); else moba_unit_body<false>(Kb, Vb, Q, rowi, j, ktn, fr, g4, O, mrun, lrun);
#pragma unroll
        for (int cg = 0; cg < 2; ++cg) {
            float lt = lrun[cg]; lt += __shfl_xor(lt, 16); lt += __shfl_xor(lt, 32);
            const float inv = 1.0f / lt;
            const int slot = own ? 3 : __popc(smv[cg] & ((1u << j) - 1u));
            if (valid[cg]) {
                bf16_t* op = ((bf16_t*)(p.ws + OFF_opart)) + (((size_t)bh * SEQ + rowi[cg]) * 4 + slot) * 128 + 4 * g4;
#pragma unroll
                for (int dt = 0; dt < 8; ++dt) *(u32x2*)(op + 16 * dt) = pack4(O[cg][dt] * inv);
                if (g4 == 0) { float* mlp = ((float*)(p.ws + OFF_ml)) + (((size_t)bh * SEQ + rowi[cg]) * 4 + slot) * 2; mlp[0] = mrun[cg]; mlp[1] = lt; }
            }
        }
    }
    __syncthreads();
}
__device__ __forceinline__ void moba_combine(const Params& p, int tid) {
    const int lane = tid & 63, w = tid >> 6, sub = lane >> 4, dl = lane & 15;
    const int stride = gridDim.x * 32;
    for (int pr0 = (blockIdx.x * 8 + w) * 4 + sub; pr0 < MT * 8; pr0 += 2 * stride) {
        int tok[2], hh[2]; size_t rb[2]; unsigned sm[2];
#pragma unroll
        for (int k = 0; k < 2; ++k) { const int pr = pr0 + k * stride < MT * 8 ? pr0 + k * stride : pr0; tok[k] = pr >> 3; hh[k] = pr & 7; rb[k] = (size_t)((tok[k] >> 12) * 8 + hh[k]) * SEQ + (tok[k] & (SEQ - 1)); }
#pragma unroll
        for (int k = 0; k < 2; ++k) sm[k] = ((const unsigned*)(p.ws + OFF_selm))[rb[k]];
        f32x4 ml0[2], ml1[2]; u32x4 ov[2][4];
#pragma unroll
        for (int k = 0; k < 2; ++k) { const f32x4* mlp = (const f32x4*)(((const float*)(p.ws + OFF_ml)) + rb[k] * 8); ml0[k] = mlp[0]; ml1[k] = mlp[1];
            const bf16_t* op = ((const bf16_t*)(p.ws + OFF_opart)) + rb[k] * 512 + 8 * dl;
#pragma unroll
            for (int sl = 0; sl < 4; ++sl) ov[k][sl] = *(const u32x4*)(op + sl * 128); }
#pragma unroll
        for (int k = 0; k < 2; ++k) {
            const int nsel = __popc(sm[k]);
            const float mraw[4] = {ml0[k][0], ml0[k][2], ml1[k][0], ml1[k][2]}, lraw[4] = {ml0[k][1], ml0[k][3], ml1[k][1], ml1[k][3]};
            float mm[4]; bool on[4];
#pragma unroll
            for (int sl = 0; sl < 4; ++sl) { on[sl] = (sl == 3) || (sl < nsel); mm[sl] = on[sl] ? mraw[sl] : -1.0e30f; }
            const float M = fmaxf(fmaxf(mm[0], mm[1]), fmaxf(mm[2], mm[3]));
            float wsum = 0.f; f32x4 a0 = {0.f, 0.f, 0.f, 0.f}, a1 = a0;
#pragma unroll
            for (int sl = 0; sl < 4; ++sl) {
                const float wgt = on[sl] ? lraw[sl] * ex2(mm[sl] - M) : 0.f; wsum += wgt; const u32x4 v = ov[k][sl];
                const f32x4 x0 = {bflo(v.x), bfhi(v.x), bflo(v.y), bfhi(v.y)}, x1 = {bflo(v.z), bfhi(v.z), bflo(v.w), bfhi(v.w)};
#pragma unroll
                for (int e = 0; e < 4; ++e) { a0[e] += on[sl] ? x0[e] * wgt : 0.f; a1[e] += on[sl] ? x1[e] * wgt : 0.f; }
            }
            const float inv = 1.0f / wsum;
            if (k == 0 || pr0 + stride < MT * 8) *(bf16x8*)(((bf16_t*)(p.ws + OFF_yA)) + (size_t)tok[k] * 2048 + 512 + hh[k] * 128 + 8 * dl) = pack8(a0 * inv, a1 * inv);
        }
    }
}

__device__ __forceinline__ void gmlp_unit(const Params& p, LAS unsigned char* lds, int unit, int tid, int layer) {
    const int grp = unit & 3, cc = (unit >> 2) & 31, b = unit >> 7;
    const int tok0 = b * SEQ + cc * 128;
    LAS float* red = (LAS float*)lds; LAS float* sMean = red + 1024; LAS float* sRstd = sMean + 128;
    LAS bf16_t* vn = (LAS bf16_t*)(lds + 8192);
    {
        const int chunk = tid & 15, chg = tid >> 4;
        const bf16_t* src = ((bf16_t*)(p.ws + OFF_ZT)) + (size_t)(TVC + chg) * MT + tok0 + chunk * 8;
        u32x4 v[16];
#pragma unroll
        for (int i = 0; i < 16; ++i) v[i] = *(const u32x4*)(src + (size_t)(32 * i) * MT);
        float s8[8], q8[8];
#pragma unroll
        for (int e = 0; e < 8; ++e) { s8[e] = 0.f; q8[e] = 0.f; }
#pragma unroll
        for (int i = 0; i < 16; ++i) {
            const float x[8] = {bflo(v[i].x), bfhi(v[i].x), bflo(v[i].y), bfhi(v[i].y), bflo(v[i].z), bfhi(v[i].z), bflo(v[i].w), bfhi(v[i].w)};
#pragma unroll
            for (int e = 0; e < 8; ++e) { s8[e] += x[e]; q8[e] += x[e] * x[e]; }
        }
        LAS float* red2 = (LAS float*)(lds + 49152);
#pragma unroll
        for (int e = 0; e < 8; ++e) { red2[(chg * 128 + chunk * 8 + e) * 2] = s8[e]; red2[(chg * 128 + chunk * 8 + e) * 2 + 1] = q8[e]; }
    }
    __syncthreads();
    if (tid < 128) { float s = 0.f, q = 0.f; const LAS float* red2 = (const LAS float*)(lds + 49152);
#pragma unroll 8
        for (int g = 0; g < 32; ++g) { s += red2[(g * 128 + tid) * 2]; q += red2[(g * 128 + tid) * 2 + 1]; }
        const float mean = s * (1.0f / 512.0f); const float var = fmaxf(q * (1.0f / 512.0f) - mean * mean, 0.f);
        sMean[tid] = mean; sRstd[tid] = rsqrtf(var + 1e-6f); }
    __syncthreads();
    { const int e = tid >> 2, sc = (tid & 3) * 32; const int ch = grp * 128 + e;
      const float gg = p.in[6][layer * 512 + ch], bb = p.in[7][layer * 512 + ch];
      const bf16_t* src = ((bf16_t*)(p.ws + OFF_ZT)) + (size_t)(TVC + ch) * MT + tok0 + sc;
#pragma unroll
      for (int i = 0; i < 4; ++i) { const u32x4 v = *(const u32x4*)(src + 8 * i); const int s0 = sc + 8 * i;
          const f32x4 x0 = {bflo(v.x), bfhi(v.x), bflo(v.y), bfhi(v.y)}, x1 = {bflo(v.z), bfhi(v.z), bflo(v.w), bfhi(v.w)};
          f32x4 y0, y1;
#pragma unroll
          for (int j = 0; j < 4; ++j) { y0[j] = (x0[j] - sMean[s0 + j]) * sRstd[s0 + j] * gg + bb; y1[j] = (x1[j] - sMean[s0 + 4 + j]) * sRstd[s0 + 4 + j] * gg + bb; }
          *(LAS bf16x8*)(vn + e * 136 + s0) = pack8(y0, y1); } }
    __syncthreads();
    const int lane = tid & 63, w = tid >> 6, fr = lane & 15, g4 = lane >> 4;
    const int t = 16 * w + fr;
    f32x4 acc[8];
#pragma unroll
    for (int et = 0; et < 8; ++et) acc[et] = (f32x4){0.f, 0.f, 0.f, 0.f};
    const float* wrow = p.in[8] + (((size_t)layer * 4 + grp) * 128 + t) * 128;
    const int ksmax = (16 * w + 15) >> 5;
#pragma unroll
    for (int ks = 0; ks < 4; ++ks) if (ks <= ksmax) {
        const int s0 = 32 * ks + 8 * g4;
        f32x4 w0 = *(const f32x4*)(wrow + s0), w1 = *(const f32x4*)(wrow + s0 + 4);
#pragma unroll
        for (int j = 0; j < 4; ++j) { if (s0 + j > t) w0[j] = 0.f; if (s0 + 4 + j > t) w1[j] = 0.f; }
        const bf16x8 B = pack8(w0, w1);
#pragma unroll
        for (int et = 0; et < 8; ++et) acc[et] = mfma16(*(const LAS bf16x8*)(vn + (16 * et + fr) * 136 + s0), B, acc[et]);
    }
    const float bs = p.in[9][((size_t)layer * 4 + grp) * 128 + t];
#pragma unroll
    for (int et = 0; et < 8; ++et) {
        const int e0 = 16 * et + 4 * g4;
        const f32x4 uu = unpack4(*(const u32x2*)(((bf16_t*)(p.ws + OFF_Z)) + (size_t)(tok0 + t) * NZ + ZUC + grp * 128 + e0));
        f32x4 y;
#pragma unroll
        for (int j = 0; j < 4; ++j) y[j] = uu[j] * (acc[et][j] + bs);
        *(u32x2*)(((bf16_t*)(p.ws + OFF_yA)) + (size_t)(tok0 + t) * 2048 + 1536 + grp * 128 + e0) = pack4(y);
    }
    __syncthreads();
}

__device__ __forceinline__ void final_norm(const Params& p, const float* ssq, int tid) {
    const int lane = tid & 63, w = tid >> 6;
    for (int row = blockIdx.x * 8 + w; row < MT; row += gridDim.x * 8) {
        float s = lane < 32 ? ssq[(size_t)row * 32 + lane] : 0.f;
        s = wave_sum(s);
        const float rs = rsqrtf(s * (1.0f / 2048.0f) + 1e-6f);
#pragma unroll
        for (int i = 0; i < 8; ++i) { const int k = 4 * lane + 256 * i; const f32x4 v = *(const f32x4*)(((float*)(p.ws + OFF_xres)) + (size_t)row * DM + k); const f32x4 g = *(const f32x4*)(p.in[20] + k); *(f32x4*)(p.out + (size_t)row * DM + k) = v * rs * g; }
    }
}

__global__ void __launch_bounds__(512, 2) mega(Params p) {
    extern __shared__ __attribute__((aligned(16))) unsigned char smem_[];
    LAS unsigned char* lds = (LAS unsigned char*)smem_;
    cg::grid_group grid = cg::this_grid();
    const int tid0 = threadIdx.x, G = gridDim.x, bid = blockIdx.x;
#define tid opq(tid0)
    int ph = 0;
    volatile LAS unsigned* xst = (volatile LAS unsigned*)(lds + XST_OFF);
    if (tid0 == 0) { xst[0] = 0u; xst[1] = 0u; xst[2] = 0u; xst[3] = 0u; }
    __syncthreads();
    const XcdBarrier xb = xcd_barrier_post((unsigned*)(p.ws + OFF_bar), xst);
#define PH_ON (ph >= p.ph_lo && ph < p.ph_hi)
#define PH_END do { if (PH_ON && ph + 1 < p.ph_hi) xcd_barrier(xb); ++ph; } while (0)
    if (p.ph_hi < 0) grid.sync();
    for (int rep_ = 0; rep_ < (PH_ON && PHM(0) ? 1 + REPM(0) : 0); ++rep_, (rep_ <= REPM(0) ? grid.sync() : (void)0)) prologue(p, lds, tid);
    PH_END;
#ifdef EXTRA_SYNCS
    for (int i_ = 0; i_ < EXTRA_SYNCS; ++i_) grid.sync();
#endif
    for (int l = 0; l < 2; ++l) {
        const int cur = l & 1;
        bf16_t* xbc = cur ? ((bf16_t*)(p.ws + OFF_xb1)) : ((bf16_t*)(p.ws + OFF_xb0)); bf16_t* xbn = cur ? ((bf16_t*)(p.ws + OFF_xb0)) : ((bf16_t*)(p.ws + OFF_xb1));
        float* ssc = cur ? ((float*)(p.ws + OFF_ssq1)) : ((float*)(p.ws + OFF_ssq0)); float* ssn = cur ? ((float*)(p.ws + OFF_ssq0)) : ((float*)(p.ws + OFF_ssq1));
        const bf16_t* wti = ((bf16_t*)(p.ws + OFF_wt_in)) + (size_t)l * NWIN * 2048;
        for (int rep_ = 0; rep_ < (PH_ON && PHM(1) ? 1 + REPM(1) : 0); ++rep_, (rep_ <= REPM(1) ? grid.sync() : (void)0)) {
            gates_phase(p, l, l == 0 ? p.in[0] : ((float*)(p.ws + OFF_xres)), tid);
            { EpiZ E{((bf16_t*)(p.ws + OFF_Z)), ssc, ((float*)(p.ws + OFF_rope))}; run_gemm(lds, xbc, wti, MT, NZ, DM, E); }
            { EpiZT E{((bf16_t*)(p.ws + OFF_ZT)), ssc}; run_gemm(lds, wti + (size_t)NZ * 2048, xbc, NTR, MT, DM, E); }
        }
        PH_END;
        for (int rep_ = 0; rep_ < (PH_ON && PHM(2) ? 1 + REPM(2) : 0); ++rep_, (rep_ <= REPM(2) ? grid.sync() : (void)0)) {
            for (int u = bid; u < 512; u += G) mlstm_a_unit(p, lds, u, tid);
            for (int u = bid; u < 256; u += G) kmean_unit(p, lds, u, tid);
            if (bid == 0 && tid < 256) ((unsigned*)(p.ws + OFF_cnt))[tid] = 0u;
            for (int u = bid; u < 256; u += G) gmlp_unit(p, lds, u, tid, l);
        }
        PH_END;
        for (int rep_ = 0; rep_ < (PH_ON && PHM(3) ? 1 + REPM(3) : 0); ++rep_, (rep_ <= REPM(3) ? grid.sync() : (void)0)) {
            mlstm_scan(p, tid);
            for (int u = bid; u < 512; u += G) moba_gate_unit(p, lds, u, tid);
        }
        PH_END;
        for (int rep_ = 0; rep_ < (PH_ON && PHM(4) ? 1 + REPM(4) : 0); ++rep_, (rep_ <= REPM(4) ? grid.sync() : (void)0)) { moba_attn_phase(p, lds, tid); for (int u = bid; u < 512; u += G) mlstm_c_unit(p, lds, u, tid, l); }
        PH_END;
        for (int rep_ = 0; rep_ < (PH_ON && PHM(11) ? 1 + REPM(11) : 0); ++rep_, (rep_ <= REPM(11) ? grid.sync() : (void)0)) { moba_combine(p, tid); }
        PH_END;
        for (int rep_ = 0; rep_ < (PH_ON && PHM(5) ? 1 + REPM(5) : 0); ++rep_, (rep_ <= REPM(5) ? grid.sync() : (void)0)) {
            { EpiMerge E{((bf16_t*)(p.ws + OFF_Z)), ((bf16_t*)(p.ws + OFF_mergedb))}; run_gemm<EpiMerge, MergeOrder>(lds, ((bf16_t*)(p.ws + OFF_yA)), ((bf16_t*)(p.ws + OFF_wt_a)) + (size_t)l * 2048 * 2048, MT, DM, DM, E); }
        }
        PH_END;
        for (int rep_ = 0; rep_ < (PH_ON && PHM(6) ? 1 + REPM(6) : 0); ++rep_, (rep_ <= REPM(6) ? grid.sync() : (void)0)) { EpiRes<0> E{l == 0 ? p.in[0] : ((float*)(p.ws + OFF_xres)), ((float*)(p.ws + OFF_xres)), xbn, ssn, nullptr, nullptr}; run_gemm(lds, ((bf16_t*)(p.ws + OFF_mergedb)), ((bf16_t*)(p.ws + OFF_wt_out)) + (size_t)l * 2048 * 2048, MT, DM, DM, E); }
        PH_END;
        for (int rep_ = 0; rep_ < (PH_ON && PHM(7) ? 1 + REPM(7) : 0); ++rep_, (rep_ <= REPM(7) ? grid.sync() : (void)0)) {
            { EpiUp E{((bf16_t*)(p.ws + OFF_hidden)), ssn}; run_gemm(lds, xbn, ((bf16_t*)(p.ws + OFF_wt_up)) + (size_t)l * 8192 * 2048, MT, FF, DM, E); }
            { EpiP E{((bf16_t*)(p.ws + OFF_pple)), DM}; run_gemm(lds, ((bf16_t*)(p.ws + OFF_pb)) + (size_t)l * MT * 256, ((bf16_t*)(p.ws + OFF_wt_pe)) + (size_t)l * 2048 * 256, MT, DM, 256, E); }
        }
        PH_END;
        for (int rep_ = 0; rep_ < (PH_ON && PHM(8) ? 1 + REPM(8) : 0); ++rep_, (rep_ <= REPM(8) ? grid.sync() : (void)0)) { EpiRes<0> E{((float*)(p.ws + OFF_xres)), ((float*)(p.ws + OFF_xres)), xbc, ssc, nullptr, nullptr}; run_gemm(lds, ((bf16_t*)(p.ws + OFF_hidden)), ((bf16_t*)(p.ws + OFF_wt_down)) + (size_t)l * 2048 * 8192, MT, DM, FF, E); }
        PH_END;
        for (int rep_ = 0; rep_ < (PH_ON && PHM(9) ? 1 + REPM(9) : 0); ++rep_, (rep_ <= REPM(9) ? grid.sync() : (void)0)) { EpiRes<1> E{((float*)(p.ws + OFF_xres)), ((float*)(p.ws + OFF_xres)), l == 1 ? nullptr : xbn, ssn, ssc, ((bf16_t*)(p.ws + OFF_pple))}; run_gemm(lds, xbc, ((bf16_t*)(p.ws + OFF_wt_pg)) + (size_t)l * 2048 * 2048, MT, DM, DM, E); }
        PH_END;
    }
    for (int rep_ = 0; rep_ < (PH_ON && PHM(10) ? 1 + REPM(10) : 0); ++rep_, (rep_ <= REPM(10) ? grid.sync() : (void)0)) final_norm(p, ((float*)(p.ws + OFF_ssq0)), tid);
#undef PH_ON
#undef PH_END
#undef tid
}

__global__ void fill_diag(float* o, int n, float v) { for (int i = blockIdx.x * blockDim.x + threadIdx.x; i < n; i += gridDim.x * blockDim.x) o[i] = v; }
extern "C" void kernel_launch(void* const* d_in, const int* in_sizes, int n_in, void* d_out, int out_size, void* d_ws, size_t ws_size, hipStream_t stream) {
    static int grid_blocks = 0;
    if (!grid_blocks) {
        int dev = 0, cus = 0, per_cu = 0;
        hipGetDevice(&dev);
        hipDeviceGetAttribute(&cus, hipDeviceAttributeMultiprocessorCount, dev);
        hipFuncSetAttribute((const void*)mega, hipFuncAttributeMaxDynamicSharedMemorySize, LDS_BYTES);
        hipOccupancyMaxActiveBlocksPerMultiprocessor(&per_cu, (const void*)mega, 512, LDS_BYTES);
        if (per_cu < 1) { fprintf(stderr, "kernel_launch: occupancy query says %d blocks per CU\n", per_cu); per_cu = 1; }
        grid_blocks = cus * 1;
        (void)hipGetLastError();
    }
    Params p{};
    for (int i = 0; i < 21; ++i) p.in[i] = (const float*)d_in[i];
    p.out = (float*)d_out; p.ws = (unsigned char*)d_ws;
    if (n_in != 21 || OFF_END > ws_size) { fill_diag<<<1024, 256, 0, stream>>>((float*)d_out, out_size, n_in != 21 ? 50000.f + n_in : (float)(ws_size >> 20)); return; }
    (void)hipMemsetAsync((unsigned char*)d_ws + OFF_bar, 0, (size_t)XCD_BAR_WORDS * 4, stream);
#if N_LAUNCH_MODE == 0
    p.ph_lo = 0; p.ph_hi = PHASE_LIMIT;
    void* args[] = {&p};
    hipError_t e = hipLaunchCooperativeKernel((const void*)mega, dim3(grid_blocks), dim3(512), args, LDS_BYTES, stream);
    if (e != hipSuccess) fprintf(stderr, "kernel_launch: cooperative launch failed: %s (grid %d)\n", hipGetErrorString(e), grid_blocks);
#else
    for (int ph = 0; ph < PHASE_LIMIT; ++ph) { p.ph_lo = ph; p.ph_hi = ph + 1; hipLaunchKernelGGL(mega, dim3(grid_blocks), dim3(512), LDS_BYTES, stream, p); }
#endif
}
```
